# Optimizing an MI355X kernel written in HIP

```python
import math
import jax
import jax.numpy as jnp
from jax import lax
import numpy as np


D_MODEL = 1024
BATCH = 4
SEQ = 8192
DEPTH = 2

N_META = 16
POOL_GROUPS = 4
POOL_WINDOWS = (2, 4, 8, 16)
POOL_WIDTH = D_MODEL // 2
POOL_GROUP_DIM = POOL_WIDTH // POOL_GROUPS
DIFF_HEADS = 4
DIFF_QK_DIM = D_MODEL // 16
DIFF_V_DIM = 2 * DIFF_QK_DIM
Q_WIDTH = DIFF_HEADS * 2 * DIFF_QK_DIM
ATTN_WIDTH = DIFF_HEADS * DIFF_V_DIM
N_BRANCHES = 2
IN_COLS = POOL_WIDTH + 2 * Q_WIDTH + ATTN_WIDTH + N_BRANCHES * D_MODEL
REL_BUCKETS = 32
REL_MAX_DIST = 128
Q_BLOCK = 128
D_FF = 7 * D_MODEL // 2
N_EXPERTS = 8
TOP_K = 2
N_DENSE = (DEPTH + 1) // 2
N_MOE = DEPTH // 2
RMS_EPS = 1e-6
SUBLN_EPS = 1e-5

kernel_name = 'hybrid_pool_diffattn_moe_block'


def rmsnorm(x, g, eps=RMS_EPS):
    xf = x.astype(jnp.float32)
    y = xf * lax.rsqrt(jnp.mean(xf * xf, axis=-1, keepdims=True) + eps)
    return (y * g.astype(jnp.float32)).astype(x.dtype)


def t5_causal_bucket(q_pos, k_pos):
    n = jnp.maximum(q_pos[:, None] - k_pos[None, :], 0)
    max_exact = REL_BUCKETS // 2
    nf = jnp.maximum(n, 1).astype(jnp.float32)
    large = max_exact + (jnp.log(nf / max_exact) / math.log(REL_MAX_DIST / max_exact)
                         * (REL_BUCKETS - max_exact)).astype(jnp.int32)
    large = jnp.minimum(large, REL_BUCKETS - 1)
    return jnp.where(n < max_exact, n, large)


def pool_mixer(u, group_w, scale):
    b, L, _ = u.shape
    uf = u.astype(jnp.float32).reshape(b, L, POOL_GROUPS, POOL_GROUP_DIM)
    cs = jnp.pad(jnp.cumsum(uf, axis=1), ((0, 0), (1, 0), (0, 0), (0, 0)))
    t = jnp.arange(L)
    avgs = []
    for g, w in enumerate(POOL_WINDOWS):
        csg = cs[:, :, g]
        prev = jnp.pad(csg, ((0, 0), (w - 1, 0), (0, 0)))[:, :L]
        cnt = jnp.minimum(t + 1, w).astype(jnp.float32)[None, :, None]
        avgs.append((csg[:, 1:] - prev) / cnt)
    mixed = (jnp.stack(avgs, axis=2) - uf).astype(u.dtype)
    y = jnp.einsum('blgc,gcd->blgd', mixed, group_w)
    return y.reshape(b, L, POOL_WIDTH) * scale


def diff_attention(q, k, v, rel_bias, lam, lambda_init, subln_gain):
    b, L, H = q.shape[0], q.shape[1], q.shape[2]
    n_blocks = -(-L // Q_BLOCK)
    Lp = n_blocks * Q_BLOCK
    pad5 = ((0, 0), (0, Lp - L), (0, 0), (0, 0), (0, 0))
    q = jnp.pad(q, pad5) * (DIFF_QK_DIM ** -0.5)
    k = jnp.pad(k, pad5)
    v = jnp.pad(v, pad5[:4])
    k_pos = jnp.arange(Lp)
    q_blocks = q.reshape(b, n_blocks, Q_BLOCK, H, 2, DIFF_QK_DIM).transpose(1, 0, 2, 3, 4, 5)
    starts = jnp.arange(n_blocks) * Q_BLOCK

    def one_block(args):
        qb, s = args
        q_pos = s + jnp.arange(Q_BLOCK)
        bias = rel_bias[t5_causal_bucket(q_pos, k_pos)]
        bias = bias.transpose(2, 0, 1).astype(jnp.float32)
        logits = jnp.einsum('bqhcd,bkhcd->bhcqk', qb, k).astype(jnp.float32)
        logits = logits + bias[None, :, None]
        causal = k_pos[None, :] <= q_pos[:, None]
        logits = jnp.where(causal, logits, -jnp.inf)
        p = jax.nn.softmax(logits, axis=-1)
        a = p[:, :, 0] - lam * p[:, :, 1]
        return jnp.einsum('bhqk,bkhd->bqhd', a.astype(v.dtype), v)

    o = lax.map(one_block, (q_blocks, starts))
    o = o.transpose(1, 0, 2, 3, 4).reshape(b, Lp, H, DIFF_V_DIM)[:, :L]
    o = rmsnorm(o, subln_gain, SUBLN_EPS) * (1.0 - lambda_init)
    return o.reshape(b, L, H * DIFF_V_DIM)


def swiglu(h, wg, wu, wd):
    return (jax.nn.silu(h @ wg) * (h @ wu)) @ wd


def moe_swiglu(h, router, wg, wu, wd):
    logits = jnp.einsum('bld,de->ble', h, router).astype(jnp.float32)
    top_vals, top_idx = lax.top_k(logits, TOP_K)
    top_w = jax.nn.softmax(top_vals, axis=-1)
    combine = jnp.sum(jax.nn.one_hot(top_idx, N_EXPERTS, dtype=jnp.float32) * top_w[..., None], axis=-2)
    combine = combine.astype(h.dtype)
    out = jnp.zeros_like(h)
    for e in range(N_EXPERTS):
        out = out + combine[..., e:e + 1] * swiglu(h, wg[e], wu[e], wd[e])
    return out


def setup_inputs(seed: int = 0) -> dict:
    key = jax.random.key(seed)
    ks = jax.random.split(key, 24)
    f32 = jnp.float32

    def nrm(k, shape, scale):
        return jax.random.normal(k, shape, f32) * scale

    def gain(k, shape):
        return 1.0 + 0.02 * jax.random.normal(k, shape, f32)

    return {
        'x': nrm(ks[0], (BATCH, SEQ, D_MODEL), 1.0),
        'meta_tokens': nrm(ks[1], (N_META, D_MODEL), 1.0),
        'rel_bias': nrm(ks[2], (REL_BUCKETS, DIFF_HEADS), 0.5),
        'norm_mix': gain(ks[3], (DEPTH, D_MODEL)),
        'w_in': nrm(ks[4], (DEPTH, D_MODEL, IN_COLS), D_MODEL ** -0.5),
        'pool_group_w': nrm(ks[5], (DEPTH, POOL_GROUPS, POOL_GROUP_DIM, POOL_GROUP_DIM), POOL_GROUP_DIM ** -0.5),
        'pool_scale': 1.0 + 0.1 * jax.random.normal(ks[6], (DEPTH, POOL_WIDTH), f32),
        'lambda_q1': nrm(ks[7], (DEPTH, DIFF_QK_DIM), 0.1),
        'lambda_k1': nrm(ks[8], (DEPTH, DIFF_QK_DIM), 0.1),
        'lambda_q2': nrm(ks[9], (DEPTH, DIFF_QK_DIM), 0.1),
        'lambda_k2': nrm(ks[10], (DEPTH, DIFF_QK_DIM), 0.1),
        'subln_gain': gain(ks[11], (DEPTH, DIFF_V_DIM)),
        'w_pool_up': nrm(ks[12], (DEPTH, POOL_WIDTH, D_MODEL), POOL_WIDTH ** -0.5),
        'w_attn_up': nrm(ks[13], (DEPTH, ATTN_WIDTH, D_MODEL), ATTN_WIDTH ** -0.5),
        'w_out': nrm(ks[14], (DEPTH, D_MODEL, D_MODEL), D_MODEL ** -0.5),
        'norm_ffn': gain(ks[15], (DEPTH, D_MODEL)),
        'dense_w_gate': nrm(ks[16], (N_DENSE, D_MODEL, D_FF), D_MODEL ** -0.5),
        'dense_w_up': nrm(ks[17], (N_DENSE, D_MODEL, D_FF), D_MODEL ** -0.5),
        'dense_w_down': nrm(ks[18], (N_DENSE, D_FF, D_MODEL), D_FF ** -0.5),
        'moe_router': nrm(ks[19], (N_MOE, D_MODEL, N_EXPERTS), D_MODEL ** -0.5),
        'moe_w_gate': nrm(ks[20], (N_MOE, N_EXPERTS, D_MODEL, D_FF), D_MODEL ** -0.5),
        'moe_w_up': nrm(ks[21], (N_MOE, N_EXPERTS, D_MODEL, D_FF), D_MODEL ** -0.5),
        'moe_w_down': nrm(ks[22], (N_MOE, N_EXPERTS, D_FF, D_MODEL), D_FF ** -0.5),
        'final_norm': gain(ks[23], (D_MODEL,)),
    }


def reference(x, meta_tokens, rel_bias, norm_mix, w_in, pool_group_w, pool_scale,
              lambda_q1, lambda_k1, lambda_q2, lambda_k2, subln_gain,
              w_pool_up, w_attn_up, w_out, norm_ffn,
              dense_w_gate, dense_w_up, dense_w_down,
              moe_router, moe_w_gate, moe_w_up, moe_w_down, final_norm):
    b = x.shape[0]
    f32 = jnp.float32
    meta = jnp.broadcast_to(meta_tokens[None].astype(x.dtype), (b, N_META, D_MODEL))
    h = jnp.concatenate([meta, x], axis=1)
    L = h.shape[1]
    splits = [POOL_WIDTH, POOL_WIDTH + Q_WIDTH, POOL_WIDTH + 2 * Q_WIDTH,
              POOL_WIDTH + 2 * Q_WIDTH + ATTN_WIDTH]
    for layer in range(DEPTH):
        hn = rmsnorm(h, norm_mix[layer])
        proj = hn @ w_in[layer]
        u_pool, q, k, v, gate_logits = jnp.split(proj, splits, axis=-1)
        a_out = pool_mixer(u_pool, pool_group_w[layer], pool_scale[layer])
        lambda_init = 0.8 - 0.6 * math.exp(-0.3 * layer)
        lam = (jnp.exp(jnp.sum(lambda_q1[layer].astype(f32) * lambda_k1[layer].astype(f32)))
               - jnp.exp(jnp.sum(lambda_q2[layer].astype(f32) * lambda_k2[layer].astype(f32)))
               + lambda_init)
        q = q.reshape(b, L, DIFF_HEADS, 2, DIFF_QK_DIM)
        k = k.reshape(b, L, DIFF_HEADS, 2, DIFF_QK_DIM)
        v = v.reshape(b, L, DIFF_HEADS, DIFF_V_DIM)
        b_out = diff_attention(q, k, v, rel_bias, lam, lambda_init, subln_gain[layer]).astype(h.dtype)
        gates = jax.nn.sigmoid(gate_logits.astype(f32)).astype(h.dtype).reshape(b, L, N_BRANCHES, D_MODEL)
        merged = (gates[:, :, 0] * (a_out @ w_pool_up[layer])
                  + gates[:, :, 1] * (b_out @ w_attn_up[layer]))
        h = h + merged @ w_out[layer]
        hn = rmsnorm(h, norm_ffn[layer])
        j = layer // 2
        if layer % 2 == 0:
            f = swiglu(hn, dense_w_gate[j], dense_w_up[j], dense_w_down[j])
        else:
            f = moe_swiglu(hn, moe_router[j], moe_w_gate[j], moe_w_up[j], moe_w_down[j])
        h = h + f
    out = rmsnorm(h, final_norm)
    return out[:, N_META:]
```

```cpp
#include <hip/hip_runtime.h>
#include <cstdio>
#include <cstdint>

#ifndef PROBE_DUP
#define PROBE_DUP 0
#endif
#ifndef USE_MFMA_ATTN
#define USE_MFMA_ATTN 1
#endif
#ifndef USE_PG8
#define USE_PG8 1
#endif
#ifndef NLAUNCH
#define NLAUNCH 1
#endif

#define GAS __attribute__((address_space(1)))
#define LAS __attribute__((address_space(3)))
typedef unsigned short bf16;
typedef short bf16x8 __attribute__((ext_vector_type(8)));
typedef float f32x4 __attribute__((ext_vector_type(4)));
typedef float f32x2 __attribute__((ext_vector_type(2)));
typedef unsigned u32x4 __attribute__((ext_vector_type(4)));
typedef unsigned u32x2 __attribute__((ext_vector_type(2)));
typedef __bf16 bf16x2_t __attribute__((ext_vector_type(2)));

constexpr int D = 1024, NB = 4, S = 8192, NMETA = 16, M = NB * S;
constexpr int NH = 4, DK = 64, DV = 128;
constexpr int NIN = 3584;
constexpr int DFF = 3584, NE = 8;
constexpr int KROWS = 64 + S;
constexpr float RMS_EPS = 1e-6f, SUBLN_EPS = 1e-5f;
constexpr float LOG2E = 1.4426950408889634f;
constexpr float C2 = 0.125f * LOG2E;
constexpr int NWAVES = 8, NTHR = 512, GRID = 256;
constexpr int MAXPANELS = 264;

constexpr size_t MiB = 1u << 20;
constexpr size_t WS_CTL = 0, CTL_ZERO_BYTES = 1 * MiB;
constexpr size_t WS_SMALL = 1 * MiB;
constexpr size_t SM_MH = WS_SMALL + 0, SM_MHN = WS_SMALL + 64 * 1024, SM_MPROJ = WS_SMALL + 96 * 1024, SM_MMIX = WS_SMALL + 352 * 1024, SM_MBOUT = WS_SMALL + 368 * 1024,
                 SM_MTMP = WS_SMALL + 384 * 1024, SM_MMERG = WS_SMALL + 448 * 1024, SM_MACT = WS_SMALL + 480 * 1024;
constexpr size_t SM_RS = WS_SMALL + 1 * MiB, SM_EW = SM_RS + 128 * 1024, SM_W0 = SM_EW + 128 * 1024, SM_W1 = SM_W0 + 128 * 1024, SM_SLOT0 = SM_W1 + 128 * 1024, SM_SLOT1 = SM_SLOT0 + 128 * 1024;
constexpr size_t SM_HIST = WS_SMALL + 2 * MiB, SM_PSTART = SM_HIST + 8192, SM_PEXP = SM_PSTART + 1024;
constexpr size_t WS_WIN = 8 * MiB;
constexpr size_t WIN_L = (size_t)NIN * D * 2;
constexpr size_t WS_WV = WS_WIN + 2 * WIN_L;
constexpr size_t WV_L = (size_t)512 * D * 2;
constexpr size_t WS_WC = WS_WV + 2 * WV_L;
constexpr size_t WC_L = (size_t)D * 512 * 2;
constexpr size_t WS_WAU = WS_WC + 2 * WC_L;
constexpr size_t WS_WOUT = WS_WAU + 2 * WC_L;
constexpr size_t WOUT_L = (size_t)D * D * 2;
constexpr size_t WS_WGU = WS_WOUT + 2 * WOUT_L;
constexpr size_t WS_WD = WS_WGU + (size_t)2 * DFF * D * 2;
constexpr size_t WS_WN_END = WS_WD + (size_t)D * DFF * 2;
static_assert(WS_WN_END <= 54 * MiB, "non-MoE weights");
constexpr size_t WS_HN = 54 * MiB;
constexpr size_t WS_AMIX = WS_HN, WS_ABOUT = WS_HN + 32 * MiB;
constexpr size_t WS_U = 118 * MiB;
constexpr int UROWS = NMETA + S;
constexpr size_t WS_VT = 150 * MiB + 128 * 1024;
constexpr size_t WS_Q = 183 * MiB;
constexpr size_t WS_K = 215 * MiB;
constexpr size_t WS_G0 = 248 * MiB, WS_G1 = 312 * MiB;
constexpr size_t WS_O1S = 376 * MiB;
constexpr size_t WS_TMP = 183 * MiB;
constexpr size_t WS_MERGED = 118 * MiB;
constexpr size_t WS_ACT = 118 * MiB;
static_assert(WS_VT + (size_t)NB * NH * 128 * KROWS * 2 <= 183 * MiB && (size_t)NB * NH * 2 * KROWS * 64 * 2 <= 33 * MiB && WS_U + (size_t)NB * UROWS * 512 * 2 <= WS_VT, "U/K/VT regions");
constexpr size_t WS_WGUE = 8 * MiB;
constexpr size_t WGUE_L = (size_t)2 * DFF * D;
constexpr size_t WS_WDE = 64 * MiB;
constexpr size_t WDE_L = (size_t)D * DFF;
constexpr size_t WS_Y = 92 * MiB;
constexpr size_t WS_ACTE = 224 * MiB;
constexpr size_t WS_H = 482 * MiB;
constexpr size_t WS_END = 546 * MiB;
static_assert(WS_WGUE + 8 * WGUE_L <= WS_WDE && WS_WDE + 8 * WDE_L <= WS_Y && WS_Y + (size_t)MAXPANELS * 256 * D * 2 <= WS_ACTE && WS_ACTE + (size_t)MAXPANELS * 256 * DFF <= WS_H && WS_H + (size_t)M * D * 2 <= WS_END && (size_t)MAXPANELS * 256 * D <= (size_t)M * D * 4 && WS_O1S + 32 * MiB <= WS_H, "MoE map");
constexpr float SC_W8 = 512.f, SC_X8 = 16.f, SC_A8 = 8.f;

constexpr int CW_BAR = 4096;

constexpr int RING_BYTES = 131072;
constexpr int LDSCTL_OFF = RING_BYTES, MISC_OFF = LDSCTL_OFF + 320;
constexpr int LDS_BYTES = 147456;

#define RLX_AGENT __ATOMIC_RELAXED, __HIP_MEMORY_SCOPE_AGENT
__device__ __forceinline__ int lane_id_fresh() { int l; asm volatile("v_mbcnt_lo_u32_b32 %0, -1, 0\n\tv_mbcnt_hi_u32_b32 %0, -1, %0" : "=v"(l)); return l; }
#define LDS_WAIT() asm volatile("s_waitcnt lgkmcnt(0)" ::: "memory")
#define VM_WAIT() asm volatile("s_waitcnt vmcnt(0)" ::: "memory")
__device__ __forceinline__ unsigned cvtpk(float lo, float hi) { f32x2 v = {lo, hi}; bf16x2_t b = __builtin_convertvector(v, bf16x2_t); return __builtin_bit_cast(unsigned, b); }
__device__ __forceinline__ u32x4 pack8(f32x4 a, f32x4 b) { u32x4 w; w.x = cvtpk(a[0], a[1]); w.y = cvtpk(a[2], a[3]); w.z = cvtpk(b[0], b[1]); w.w = cvtpk(b[2], b[3]); return w; }
__device__ __forceinline__ float bflo(unsigned w) { return __builtin_bit_cast(float, w << 16); }
__device__ __forceinline__ float bfhi(unsigned w) { return __builtin_bit_cast(float, w & 0xffff0000u); }
__device__ __forceinline__ void unpack8(u32x4 w, f32x4& a, f32x4& b) { a = (f32x4){bflo(w.x), bfhi(w.x), bflo(w.y), bfhi(w.y)}; b = (f32x4){bflo(w.z), bfhi(w.z), bflo(w.w), bfhi(w.w)}; }
__device__ __forceinline__ unsigned pk4_fp8(float a, float b, float c, float d) { int p = __builtin_amdgcn_cvt_pk_fp8_f32(a, b, 0, false); p = __builtin_amdgcn_cvt_pk_fp8_f32(c, d, p, true); return (unsigned)p; }
__device__ __forceinline__ float bf2f(bf16 b) { return __builtin_bit_cast(float, (unsigned)b << 16); }
__device__ __forceinline__ bf16 f2bf(float f) { return (bf16)(cvtpk(f, 0.f) & 0xffffu); }
template <int CTRL> __device__ __forceinline__ float dpp_f(float v) { return __builtin_bit_cast(float, __builtin_amdgcn_update_dpp(0, __builtin_bit_cast(int, v), CTRL, 0xf, 0xf, true)); }
__device__ __forceinline__ float xor1_add(float v) { return v + dpp_f<0xB1>(v); }
__device__ __forceinline__ float xor2_add(float v) { return v + dpp_f<0x4E>(v); }
__device__ __forceinline__ float swap16_add(float v) { auto r = __builtin_amdgcn_permlane16_swap(__builtin_bit_cast(unsigned, v), __builtin_bit_cast(unsigned, v), false, false); return __builtin_bit_cast(float, r[0]) + __builtin_bit_cast(float, r[1]); }
__device__ __forceinline__ float swap32_add(float v) { auto r = __builtin_amdgcn_permlane32_swap(__builtin_bit_cast(unsigned, v), __builtin_bit_cast(unsigned, v), false, false); return __builtin_bit_cast(float, r[0]) + __builtin_bit_cast(float, r[1]); }
__device__ __forceinline__ float wave_sum(float v) {
    v = xor1_add(v); v = xor2_add(v); v += dpp_f<0x124>(v); v += dpp_f<0x128>(v);
    const int vi = __builtin_bit_cast(int, v);
    const float r0 = __builtin_bit_cast(float, __builtin_amdgcn_readlane(vi, 0)), r1 = __builtin_bit_cast(float, __builtin_amdgcn_readlane(vi, 16)), r2 = __builtin_bit_cast(float, __builtin_amdgcn_readlane(vi, 32)), r3 = __builtin_bit_cast(float, __builtin_amdgcn_readlane(vi, 48));
    return (r0 + r1) + (r2 + r3);
}
__device__ __forceinline__ float sigmoidf_(float x) { return __builtin_amdgcn_rcpf(1.0f + __builtin_amdgcn_exp2f(x * -LOG2E)); }
__device__ __forceinline__ f32x4 sig4(f32x4 v) { return (f32x4){sigmoidf_(v[0]), sigmoidf_(v[1]), sigmoidf_(v[2]), sigmoidf_(v[3])}; }
__device__ __forceinline__ int vperm16(int t) { const int g4 = (t >> 2) & 3; const int sg = (g4 == 1) ? 2 : (g4 == 2) ? 1 : g4; return (t & ~15) + 4 * sg + (t & 3); }

__device__ __forceinline__ int t5_bucket(int n) {
    if (n < 16) return n;
    const int th[16] = {16, 19, 21, 24, 27, 31, 35, 40, 46, 52, 59, 67, 77, 87, 99, 113};
    int b = 16;
#pragma unroll
    for (int j = 1; j < 16; ++j) b += (n >= th[j]) ? 1 : 0;
    return b;
}

#define XB_TMO      128
#define XB_XCNT(j)  (256  + 64 * (j))
#define XB_XSUB(j)  (1280 + 64 * (j))
#define XB_XGEN(j)  (2304 + 64 * (j))
#define XB_TOP      3328
#define XB_TOPGEN   3392
#define XCD_BAR_WORDS 3456
#define XB_SPIN_CAP (1u << 22)
__device__ __forceinline__ unsigned xb_ld(unsigned* p)              { return __hip_atomic_load(p, __ATOMIC_RELAXED, __HIP_MEMORY_SCOPE_AGENT); }
__device__ __forceinline__ unsigned xb_add(unsigned* p, unsigned v) { return __hip_atomic_fetch_add(p, v, __ATOMIC_RELAXED, __HIP_MEMORY_SCOPE_AGENT); }
__device__ __forceinline__ unsigned xb_xcc_id() { return (unsigned)__builtin_amdgcn_s_getreg((3 << 11) | 20) & 0xFu; }
#define XB_SPIN(cond, bar) do { unsigned _sp = 0; while (cond) { __builtin_amdgcn_s_sleep(1); \
    if ((++_sp & 255u) == 0u) { if (xb_ld(&(bar)[XB_TMO])) break; if (_sp > XB_SPIN_CAP) { atomicAdd(&(bar)[XB_TMO], 1u); break; } } } } while (0)
struct XcdBarrier { unsigned* bar; unsigned x; volatile LAS unsigned* st; };
__device__ __forceinline__ XcdBarrier xcd_barrier_post(unsigned* bar, volatile LAS unsigned* st, int tid) {
    XcdBarrier b; b.bar = bar; b.x = xb_xcc_id(); b.st = st;
    if (tid == 0) (void)xb_add(&bar[XB_XCNT(b.x)], 1u);
    return b;
}
__device__ __forceinline__ void xcd_barrier_complete(unsigned* bar, unsigned x, unsigned& nloc, unsigned& nx) {
    const unsigned G = gridDim.x * gridDim.y * gridDim.z;
    unsigned sum, cnt, mine, sp = 0u;
    for (;;) {
        sum = 0u; cnt = 0u; mine = 0u;
#pragma unroll
        for (unsigned j = 0; j < 16; ++j) { const unsigned c = xb_ld(&bar[XB_XCNT(j)]); sum += c; cnt += (c > 0u) ? 1u : 0u; mine = (j == x) ? c : mine; }
        if (sum == G) break;
        __builtin_amdgcn_s_sleep(1);
        if ((++sp & 255u) == 0u) { if (xb_ld(&bar[XB_TMO])) break; if (sp > XB_SPIN_CAP) { atomicAdd(&bar[XB_TMO], 1u); break; } }
    }
    nloc = mine > 0u ? mine : 1u; nx = cnt > 0u ? cnt : 1u;
}
__device__ __forceinline__ void xcd_barrier(const XcdBarrier& b, int wave_s) {
    asm volatile("s_waitcnt vmcnt(0)" ::: "memory");
    __syncthreads();
    if (wave_s == 0 && lane_id_fresh() == 0) {
        unsigned* bar = b.bar;
        __builtin_amdgcn_s_waitcnt(0);
        unsigned nloc = b.st[0], nx = b.st[1];
        if (nloc == 0u) { xcd_barrier_complete(bar, b.x, nloc, nx); b.st[0] = nloc; b.st[1] = nx; }
        const unsigned old = xb_add(&bar[XB_XSUB(b.x)], 1u);
        const unsigned gen = old / nloc;
        if (old + 1u == (gen + 1u) * nloc) {
            __builtin_amdgcn_fence(__ATOMIC_RELEASE, "agent");
            asm volatile("s_waitcnt vmcnt(0)" ::: "memory");
            const unsigned og = xb_add(&bar[XB_TOP], 1u);
            const unsigned tg = og / nx;
            if (og + 1u == (tg + 1u) * nx) xb_add(&bar[XB_TOPGEN], 1u);
            else XB_SPIN(xb_ld(&bar[XB_TOPGEN]) == tg, bar);
            __builtin_amdgcn_fence(__ATOMIC_ACQUIRE, "agent");
            xb_add(&bar[XB_XGEN(b.x)], 1u);
            asm volatile("s_waitcnt vmcnt(0)" ::: "memory");
        } else {
            XB_SPIN(xb_ld(&bar[XB_XGEN(b.x)]) == gen, bar);
            __builtin_amdgcn_fence(__ATOMIC_ACQUIRE, "agent");
            asm volatile("s_waitcnt vmcnt(0)" ::: "memory");
        }
    }
    __syncthreads();
}

namespace pg8 {
#define PG8_LAS __attribute__((address_space(3)))
typedef unsigned short bf16_t;
constexpr int BM = 256, BK = 64, HALF = 128, HTB = HALF * BK * 2, STAGE_BYTES = 8 * HTB, NXCD = 8, WGM = 8;
__host__ __device__ __forceinline__ int lds_byte(int r, int c) { const int st = (r >> 4) * 2 + (c >> 5), rr = r & 15, cc = c & 31, ob = rr * 64 + cc * 2; return st * 1024 + (ob ^ (((ob >> 9) & 1) << 5)); }
__host__ __device__ __forceinline__ void stage_rc(int b, int& R, int& C) { const int st = b / 1024, sb = b % 1024, swz = sb ^ (((sb >> 9) & 1) << 5); R = (st >> 1) * 16 + swz / 64; C = (st & 1) * 32 + (swz % 64) / 2; }
__host__ __device__ __forceinline__ int perm32(int rho) { const int n = rho >> 4, i = rho & 15; return 8 * (i >> 2) + 4 * n + (i & 3); }
typedef int i32x4_t __attribute__((ext_vector_type(4))); typedef int i32x8_t __attribute__((ext_vector_type(8)));
__device__ __forceinline__ i32x8_t ld32(const PG8_LAS unsigned char* p) { const i32x4_t lo = *(const PG8_LAS i32x4_t*)p, hi = *(const PG8_LAS i32x4_t*)(p + 1024); return __builtin_shufflevector(lo, hi, 0, 1, 2, 3, 4, 5, 6, 7); }
template <int OFF> __device__ __forceinline__ void glds_s(const void* sbase, unsigned voff, unsigned ldsbase) {
    asm volatile("s_add_i32 m0, %2, %3\n\ts_nop 0\n\tglobal_load_lds_dwordx4 %0, %1" :: "v"(voff), "s"(sbase), "s"(ldsbase), "i"(OFF) : "memory", "m0", "scc"); }
struct Unit { int pm, pn, pb, po; };
struct Gemm { const bf16_t* A; const bf16_t* Bt; int M, N, K; };
struct StaticOrder {
    int nM, nN, nwg, G, c;
    __host__ __device__ void init(int nM_, int nN_, int G_, int c_) { nM = nM_; nN = nN_; nwg = nM * nN; G = G_; c = c_; }
    __host__ __device__ bool next(int i, Unit& u) const { return unit_of((long)i * G + c, u); }
    __host__ __device__ bool unit_of(long L, Unit& u) const {
        if (L >= nwg) return false;
        int wgid = (int)L; { const int q = nwg / NXCD, r = nwg % NXCD, xcd = wgid % NXCD, off = wgid / NXCD; wgid = (xcd < r ? xcd * (q + 1) : r * (q + 1) + (xcd - r) * q) + off; }
        const int nig = WGM * nN, gid = wgid / nig, fm = gid * WGM, gsz = (nM - fm) < WGM ? (nM - fm) : WGM;
        u.pm = fm + ((wgid % nig) % gsz); u.pn = (wgid % nig) / gsz; u.pb = u.pn; u.po = u.pm; return true;
    }
    __device__ __forceinline__ void a_ready(const Unit&) const {}
    __device__ __forceinline__ void done(const Unit&) const {}
};
template <class Epi, class Sched, bool ALIGN_EPI = false, bool SP2 = false, bool SWAP = false, bool F8 = false>
__device__ __forceinline__ void gemm_phase(PG8_LAS unsigned char* lds, const Gemm g, const Sched& S, const Epi& E, const int tid) {
    const int wid = __builtin_amdgcn_readfirstlane(tid >> 6), lane = tid & 63, wr = wid >> 2, wc = wid & 3, fr = lane & 15, fq = lane >> 4;
    const int K = g.K, nt = F8 ? K / 128 : K / BK;
    unsigned voffA[2], voffB[2];
#pragma unroll
    for (int i = 0; i < 2; ++i) { int R, C; stage_rc(tid * 16 + i * 8192, R, C); const int Rb = Epi::PERM ? ((R & ~31) + perm32(R & 31)) : R;
        voffA[i] = F8 ? (unsigned)(R * K + C * 2) : (unsigned)(R * K + C) * 2u; voffB[i] = F8 ? (unsigned)(Rb * K + C * 2) : (unsigned)(Rb * K + C) * 2u; }
    const size_t kstep = (size_t)(BK * 2);
    const size_t hstep = F8 ? (size_t)HALF * K : (size_t)HALF * K * 2;
    const size_t tstep = 2 * hstep;
    const unsigned ldsw_u = (unsigned)__builtin_amdgcn_readfirstlane((int)((unsigned)(__UINTPTR_TYPE__)lds + (unsigned)wid * 1024u));
    const int aoff = lds_byte(wr * 64 + fr, fq * 8), boff = lds_byte(wc * 32 + fr, fq * 8);
#define PG8_SA(b, h) (((b) * 2 + (h)) * HTB)
#define PG8_SB(b, h) ((4 + (b) * 2 + (h)) * HTB)
#define PG8_STAGE(bufoff, gbase, voff) do { glds_s<(bufoff)>((const void*)(gbase), (voff)[0], ldsw_u); glds_s<(bufoff) + 8192>((const void*)(gbase), (voff)[1], ldsw_u); } while (0)
#define PG8_LDA(dst, b, h) do { if constexpr (F8) { _Pragma("unroll") for (int m = 0; m < 4; ++m) dst##8[m] = ld32(lds + PG8_SA(b, h) + aoff + m * 2048); } else { _Pragma("unroll") for (int m = 0; m < 4; ++m) _Pragma("unroll") for (int k = 0; k < 2; ++k) dst[m][k] = *(const PG8_LAS bf16x8*)(lds + PG8_SA(b, h) + aoff + m * 2048 + k * 1024); } } while (0)
#define PG8_LDB(dst, b, h) do { if constexpr (F8) { _Pragma("unroll") for (int n = 0; n < 2; ++n) dst##8[n] = ld32(lds + PG8_SB(b, h) + boff + n * 2048); } else { _Pragma("unroll") for (int n = 0; n < 2; ++n) _Pragma("unroll") for (int k = 0; k < 2; ++k) dst[n][k] = *(const PG8_LAS bf16x8*)(lds + PG8_SB(b, h) + boff + n * 2048 + k * 1024); } } while (0)
#define PG8_MMA(ai, bj, At, Bt) do { __builtin_amdgcn_s_setprio(1); if constexpr (F8) { _Pragma("unroll") for (int m = 0; m < 4; ++m) _Pragma("unroll") for (int n = 0; n < 2; ++n) \
        acc[ai][bj][m][n] = __builtin_amdgcn_mfma_scale_f32_16x16x128_f8f6f4(Bt##8[n], At##8[m], acc[ai][bj][m][n], 0, 0, 0, 0x7f7f7f7f, 0, 0x7f7f7f7f); } else { \
        _Pragma("unroll") for (int m = 0; m < 4; ++m) _Pragma("unroll") for (int n = 0; n < 2; ++n) _Pragma("unroll") for (int k = 0; k < 2; ++k) \
        acc[ai][bj][m][n] = SWAP ? __builtin_amdgcn_mfma_f32_16x16x32_bf16(At[m][k], Bt[n][k], acc[ai][bj][m][n], 0, 0, 0) : __builtin_amdgcn_mfma_f32_16x16x32_bf16(Bt[n][k], At[m][k], acc[ai][bj][m][n], 0, 0, 0); } __builtin_amdgcn_s_setprio(0); } while (0)
#define PG8_WAIT_V(n) asm volatile("s_waitcnt vmcnt(" #n ")" ::: "memory")
#define PG8_WAIT_L(n) asm volatile("s_waitcnt lgkmcnt(" #n ")" ::: "memory")
#define PG8_BAR __builtin_amdgcn_s_barrier()
#define PG8_SCHED __builtin_amdgcn_sched_barrier(0)
    Unit cur, nxt; int ui = 0;
    if (!S.next(0, cur)) return;
    f32x4 acc[2][2][4][2];
#pragma unroll
    for (int a = 0; a < 2; ++a)
#pragma unroll
        for (int b = 0; b < 2; ++b)
#pragma unroll
            for (int m = 0; m < 4; ++m)
#pragma unroll
                for (int n = 0; n < 2; ++n) acc[a][b][m][n] = (f32x4){0.f, 0.f, 0.f, 0.f};
    bf16x8 At[4][2], B0[2][2], B1[2][2]; i32x8_t At8[4], B08[2], B18[2];
    const char* cA = (const char*)g.A + (size_t)cur.pm * tstep; const char* cB = (const char*)g.Bt + (size_t)cur.pb * tstep;
    S.a_ready(cur);
    if constexpr (SP2) {
        PG8_STAGE(PG8_SB(0, 0), cB, voffB); PG8_STAGE(PG8_SB(0, 1), cB + hstep, voffB); PG8_STAGE(PG8_SA(0, 0), cA, voffA); PG8_STAGE(PG8_SA(0, 1), cA + hstep, voffA);
        if (wr == 1) PG8_BAR;
        PG8_WAIT_V(2); PG8_BAR;
        PG8_STAGE(PG8_SB(1, 0), cB + kstep, voffB); PG8_STAGE(PG8_SA(1, 0), cA + kstep, voffA); PG8_STAGE(PG8_SB(1, 1), cB + hstep + kstep, voffB);
        PG8_WAIT_V(6); PG8_BAR;
    } else {
        PG8_STAGE(PG8_SB(0, 0), cB, voffB); PG8_STAGE(PG8_SA(0, 0), cA, voffA); PG8_STAGE(PG8_SB(0, 1), cB + hstep, voffB); PG8_STAGE(PG8_SA(0, 1), cA + hstep, voffA);
        if (wr == 1) PG8_BAR;
        PG8_WAIT_V(4); PG8_BAR;
        PG8_STAGE(PG8_SB(1, 0), cB + kstep, voffB); PG8_STAGE(PG8_SA(1, 0), cA + kstep, voffA); PG8_STAGE(PG8_SB(1, 1), cB + hstep + kstep, voffB);
        PG8_WAIT_V(6); PG8_BAR;
    }
    for (;;) {
        const bool has_next = S.next(ui + 1, nxt);
        const char* nA = has_next ? (const char*)g.A + (size_t)nxt.pm * tstep : cA; const char* nB = has_next ? (const char*)g.Bt + (size_t)nxt.pb * tstep : cB;
#pragma unroll 1
        for (int t = 0; t < nt; t += 2) {
            const bool last = (t == nt - 2);
            const char* a1 = cA + (size_t)(t + 1) * kstep;
            const char* a2 = last ? nA : cA + (size_t)(t + 2) * kstep; const char* b2 = last ? nB : cB + (size_t)(t + 2) * kstep;
            const char* a3 = a2 + kstep; const char* b3 = b2 + kstep;
            if (last && has_next) S.a_ready(nxt);
            if constexpr (SP2) {
            PG8_LDB(B0, 0, 0); PG8_LDB(B1, 0, 1); PG8_SCHED; PG8_LDA(At, 0, 0); PG8_STAGE(PG8_SA(1, 1), a1 + hstep, voffA);
            PG8_WAIT_V(8); PG8_WAIT_L(0); PG8_BAR; PG8_MMA(0, 0, At, B0); PG8_MMA(0, 1, At, B1); PG8_BAR; PG8_SCHED;
            PG8_LDA(At, 0, 1); PG8_STAGE(PG8_SB(0, 0), b2, voffB); PG8_STAGE(PG8_SB(0, 1), b2 + hstep, voffB); PG8_STAGE(PG8_SA(0, 0), a2, voffA);
            PG8_WAIT_V(8); PG8_WAIT_L(0); PG8_BAR; PG8_MMA(1, 0, At, B0); PG8_MMA(1, 1, At, B1); PG8_BAR; PG8_SCHED;
            PG8_LDB(B0, 1, 0); PG8_LDB(B1, 1, 1); PG8_SCHED; PG8_LDA(At, 1, 0); PG8_STAGE(PG8_SA(0, 1), a2 + hstep, voffA);
            PG8_WAIT_V(8); PG8_WAIT_L(0); PG8_BAR; PG8_MMA(0, 0, At, B0); PG8_MMA(0, 1, At, B1); PG8_BAR; PG8_SCHED;
            PG8_LDA(At, 1, 1); PG8_STAGE(PG8_SB(1, 0), b3, voffB); PG8_STAGE(PG8_SB(1, 1), b3 + hstep, voffB); PG8_STAGE(PG8_SA(1, 0), a3, voffA);
            PG8_WAIT_V(8); PG8_WAIT_L(0); PG8_BAR; PG8_MMA(1, 0, At, B0); PG8_MMA(1, 1, At, B1); PG8_BAR; PG8_SCHED;
            } else {
            PG8_LDB(B0, 0, 0); PG8_SCHED; PG8_LDA(At, 0, 0); PG8_STAGE(PG8_SA(1, 1), a1 + hstep, voffA);
            PG8_WAIT_L(8); PG8_BAR; PG8_WAIT_L(0); PG8_MMA(0, 0, At, B0); PG8_BAR; PG8_SCHED;
            PG8_LDB(B1, 0, 1); PG8_STAGE(PG8_SB(0, 0), b2, voffB);
            PG8_BAR; PG8_WAIT_L(0); PG8_MMA(0, 1, At, B1); PG8_BAR;
            PG8_LDA(At, 0, 1); PG8_STAGE(PG8_SA(0, 0), a2, voffA);
            PG8_BAR; PG8_WAIT_L(0); PG8_MMA(1, 0, At, B0); PG8_BAR; PG8_SCHED;
            PG8_STAGE(PG8_SB(0, 1), b2 + hstep, voffB);
            PG8_WAIT_V(6); PG8_BAR; PG8_MMA(1, 1, At, B1); PG8_BAR;
            PG8_LDB(B0, 1, 0); PG8_SCHED; PG8_LDA(At, 1, 0); PG8_STAGE(PG8_SA(0, 1), a2 + hstep, voffA);
            PG8_WAIT_L(8); PG8_BAR; PG8_WAIT_L(0); PG8_MMA(0, 0, At, B0); PG8_BAR; PG8_SCHED;
            PG8_LDB(B1, 1, 1); PG8_STAGE(PG8_SB(1, 0), b3, voffB);
            PG8_BAR; PG8_WAIT_L(0); PG8_MMA(0, 1, At, B1); PG8_BAR;
            PG8_LDA(At, 1, 1); PG8_STAGE(PG8_SA(1, 0), a3, voffA);
            PG8_BAR; PG8_WAIT_L(0); PG8_MMA(1, 0, At, B0); PG8_BAR; PG8_SCHED;
            PG8_STAGE(PG8_SB(1, 1), b3 + hstep, voffB);
            PG8_WAIT_V(6); PG8_BAR; PG8_MMA(1, 1, At, B1); PG8_BAR;
            }
        }
        if constexpr (ALIGN_EPI) { if (wr == 0) PG8_BAR; }
        if constexpr (!Epi::AFTER_DRAIN) { E(acc, cur, wr, wc, fr, fq); S.done(cur); }
        if (!has_next) break;
#pragma unroll
        for (int a = 0; a < 2; ++a)
#pragma unroll
            for (int b = 0; b < 2; ++b)
#pragma unroll
                for (int m = 0; m < 4; ++m)
#pragma unroll
                    for (int n = 0; n < 2; ++n) acc[a][b][m][n] = (f32x4){0.f, 0.f, 0.f, 0.f};
        cur = nxt; cA = nA; cB = nB; ++ui;
        if constexpr (ALIGN_EPI) { if (wr == 1) PG8_BAR; }
    }
    PG8_WAIT_V(0);
    if constexpr (!ALIGN_EPI) { if (wr == 0) PG8_BAR; }
    PG8_BAR;
    if constexpr (Epi::AFTER_DRAIN) { E.fused(acc, cur, wr, wc, fr, fq, lds, wid, lane); S.done(cur); }
#undef PG8_SA
#undef PG8_SB
#undef PG8_STAGE
#undef PG8_LDA
#undef PG8_LDB
#undef PG8_MMA
#undef PG8_WAIT_V
#undef PG8_WAIT_L
#undef PG8_BAR
#undef PG8_SCHED
}
}

struct Args { const float* in[24]; float* out; unsigned char* ws; int ph_lo, ph_hi; };
struct Frame {
    LAS unsigned char* lds; unsigned char* ws; float* out;
    int tid, lane, wave, gw, NGW, G, blk;
};
typedef const __attribute__((address_space(4))) Args* KArgs;
__device__ __forceinline__ KArgs kargs() { KArgs p = (KArgs)__builtin_amdgcn_kernarg_segment_ptr(); asm volatile("" : "+s"(p)); return p; }
__device__ __forceinline__ Frame relaunder(const Frame& F0) {
    Frame F = F0;
    { KArgs a = kargs(); F.ws = a->ws; F.out = a->out; }
    asm volatile("" : "+s"(F.wave), "+s"(F.gw), "+s"(F.blk));
    F.lane = lane_id_fresh(); F.tid = F.wave * 64 + F.lane;
    return F;
}
enum { I_X = 0, I_META, I_RELB, I_NMIX, I_WIN, I_PGW, I_PSC, I_LQ1, I_LK1, I_LQ2, I_LK2, I_SUBLN, I_WPU, I_WAU, I_WOUT, I_NFFN, I_DG, I_DU, I_DD, I_ROUTER, I_MG, I_MU, I_MD, I_FNORM };

template <int MODE> struct G16Acc { static constexpr int NA = (MODE == 1) ? 4 : 2; f32x4 a[NA]; };
template <int MODE>
__device__ __forceinline__ void g16_core(const bf16* __restrict__ A, int lda, const bf16* __restrict__ Bt, int ldb, int kb, int ke, int m0, int cg, int lane, G16Acc<MODE>& R) {
    const int fr = lane & 15, fq = lane >> 4;
    constexpr int NA = G16Acc<MODE>::NA;
#pragma unroll
    for (int j = 0; j < NA; ++j) R.a[j] = (f32x4){0.f, 0.f, 0.f, 0.f};
    const bf16* ap = A + (size_t)(m0 + fr) * lda + 8 * fq;
    const bf16* bp[NA];
    const int n0 = 32 * cg;
    if constexpr (MODE == 0) { const int pr = 8 * (fr >> 2) + (fr & 3);
#pragma unroll
        for (int j = 0; j < 2; ++j) bp[j] = Bt + (size_t)(n0 + pr + 4 * j) * ldb + 8 * fq; }
    else if constexpr (MODE == 1) { const int pr = 8 * (fr >> 2) + (fr & 3); const int gb = 256 * (n0 >> 7) + (n0 & 127);
#pragma unroll
        for (int j = 0; j < 2; ++j) { bp[j] = Bt + (size_t)(gb + pr + 4 * j) * ldb + 8 * fq; bp[2 + j] = Bt + (size_t)(gb + 128 + pr + 4 * j) * ldb + 8 * fq; } }
    else {
#pragma unroll
        for (int j = 0; j < 2; ++j) bp[j] = Bt + (size_t)(n0 + 16 * j + fr) * ldb + 8 * fq; }
#pragma unroll 2
    for (int k0 = kb; k0 < ke; k0 += 64) {
        bf16x8 a[2], b[2][NA];
#pragma unroll
        for (int q = 0; q < 2; ++q) { a[q] = *(const bf16x8*)(ap + k0 + 32 * q);
#pragma unroll
            for (int j = 0; j < NA; ++j) b[q][j] = *(const bf16x8*)(bp[j] + k0 + 32 * q); }
        __builtin_amdgcn_sched_barrier(0);
#pragma unroll
        for (int q = 0; q < 2; ++q)
#pragma unroll
            for (int j = 0; j < NA; ++j) {
                if (MODE == 2) R.a[j] = __builtin_amdgcn_mfma_f32_16x16x32_bf16(a[q], b[q][j], R.a[j], 0, 0, 0);
                else R.a[j] = __builtin_amdgcn_mfma_f32_16x16x32_bf16(b[q][j], a[q], R.a[j], 0, 0, 0);
            }
    }
}
template <int MODE, class Epi>
__device__ __forceinline__ void g16_epi(const G16Acc<MODE>& R, int cg, int lane, const Epi& E, int rowout0) {
    const int fr = lane & 15, fq = lane >> 4, n0 = 32 * cg;
    if constexpr (MODE == 0) E.put8(rowout0 + fr, n0 + 8 * fq, R.a[0], R.a[1]);
    else if constexpr (MODE == 1) E.put8x2(rowout0 + fr, n0 + 8 * fq, R.a[0], R.a[1], R.a[2], R.a[3]);
    else {
#pragma unroll
        for (int j = 0; j < 2; ++j) E.putT(rowout0 + 4 * fq, n0 + 16 * j + fr, R.a[j]); }
}
template <int MODE, class Epi>
__device__ __forceinline__ void g16_item(const bf16* __restrict__ A, int lda, const bf16* __restrict__ Bt, int ldb, int K, int m0, int cg, int lane, const Epi& E, int rowout0) {
    G16Acc<MODE> R; g16_core<MODE>(A, lda, Bt, ldb, 0, K, m0, cg, lane, R); g16_epi<MODE>(R, cg, lane, E, rowout0);
}
template <int MODE, class Epi>
__device__ __forceinline__ void g16_phase(const Frame& F, const bf16* A, int lda, const bf16* Bt, int ldb, int K, int nstrips, int ncg, const Epi& E) {
    const long tot = (long)nstrips * ncg;
    for (long it = F.gw; it < tot; it += F.NGW) { const int strip = (int)(it / ncg), cg = (int)(it % ncg); g16_item<MODE>(A, lda, Bt, ldb, K, strip * 16, cg, F.lane, E, strip * 16); }
}
template <int MODE, class Epi>
__device__ __forceinline__ void g16_meta(const Frame& F, const bf16* A, int lda, const bf16* Bt, int ldb, int K, int ncg, const Epi& E) {
    constexpr int NA = G16Acc<MODE>::NA;
    LAS f32x4* part = (LAS f32x4*)(F.lds);
    for (int it = F.blk; it < ncg; it += F.G) {
        const int kw = K / NWAVES;
        G16Acc<MODE> R; g16_core<MODE>(A, lda, Bt, ldb, F.wave * kw, (F.wave + 1) * kw, 0, it, F.lane, R);
#pragma unroll
        for (int j = 0; j < NA; ++j) part[(F.wave * NA + j) * 64 + F.lane] = R.a[j];
        __syncthreads();
        if (F.wave == 0) {
#pragma unroll
            for (int j = 0; j < NA; ++j) { f32x4 sum = part[j * 64 + F.lane];
#pragma unroll
                for (int w = 1; w < NWAVES; ++w) sum += part[(w * NA + j) * 64 + F.lane];
                R.a[j] = sum; }
            g16_epi<MODE>(R, it, F.lane, E, 0);
        }
        __syncthreads();
    }
}

struct EpiInProj {
    bf16 *U, *Q, *Kb, *G0, *G1;
    __device__ __forceinline__ void put8(int row, int col, f32x4 lo, f32x4 hi) const {
        if (col < 512) { *(u32x4*)(U + ((size_t)(row >> 13) * UROWS + NMETA + (row & (S - 1))) * 512 + col) = pack8(lo, hi); }
        else if (col < 1536) {
            const int isk = col >= 1024; const int c = col - (isk ? 1024 : 512); const int hh = c >> 7, cc = (c >> 6) & 1, dd = c & 63; const int b = row >> 13, s = row & (S - 1);
            if (!isk) { *(u32x4*)(Q + ((size_t)(((b * NH + hh) * 2 + cc)) * S + s) * 64 + dd) = pack8(lo * C2, hi * C2); }
            else { *(u32x4*)(Kb + ((size_t)(((b * NH + hh) * 2 + cc)) * KROWS + 64 + s) * 64 + dd) = pack8(lo, hi); }
        } else {
            const int g = col - 1536;
            *(u32x4*)(G0 + (size_t)row * 2048 + g) = pack8(lo, hi);
        }
    }
};
struct EpiV {
    bf16* VT;
    __device__ __forceinline__ void putT(int row0, int col, f32x4 v) const {
        const int hh = col >> 7, d = col & 127, b = row0 >> 13, s0 = row0 & (S - 1);
        u32x2 w; w.x = cvtpk(v[0], v[1]); w.y = cvtpk(v[2], v[3]);
        *(u32x2*)(VT + ((size_t)((b * NH + hh) * 128 + d)) * KROWS + 64 + vperm16(s0)) = w;
    }
};
struct EpiInProjMeta {
    float* MPROJ; bf16* Kb; bf16* U;
    __device__ __forceinline__ void put8(int t, int col, f32x4 lo, f32x4 hi) const {
        const int oc = (col < 1536) ? col : col + 512;
        if (col < 512) { const u32x4 w = pack8(lo, hi);
#pragma unroll
            for (int b = 0; b < NB; ++b) *(u32x4*)(U + ((size_t)b * UROWS + t) * 512 + col) = w; }
        *(f32x4*)(MPROJ + (size_t)t * 4096 + oc) = lo; *(f32x4*)(MPROJ + (size_t)t * 4096 + oc + 4) = hi;
        if (col >= 1024 && col < 1536) { const int c = col - 1024; const int hh = c >> 7, cc = (c >> 6) & 1, dd = c & 63; const u32x4 w = pack8(lo, hi);
#pragma unroll
            for (int b = 0; b < NB; ++b) *(u32x4*)(Kb + ((size_t)(((b * NH + hh) * 2 + cc)) * KROWS + t) * 64 + dd) = w; }
    }
};
struct EpiVMeta {
    float* MPROJ; bf16* VT;
    __device__ __forceinline__ void putT(int t0, int col, f32x4 v) const {
#pragma unroll
        for (int r = 0; r < 4; ++r) MPROJ[(size_t)(t0 + r) * 4096 + 1536 + col] = v[r];
        const int hh = col >> 7, d = col & 127; u32x2 w; w.x = cvtpk(v[0], v[1]); w.y = cvtpk(v[2], v[3]);
#pragma unroll
        for (int b = 0; b < NB; ++b) *(u32x2*)(VT + ((size_t)((b * NH + hh) * 128 + d)) * KROWS + vperm16(t0)) = w;
    }
};
struct EpiP {
    const bf16* G0; bf16* TMP;
    static constexpr int NLOAD = 1;
    __device__ __forceinline__ void pre(int row, int col, u32x4 (&d)[1]) const { d[0] = *(const u32x4*)(G0 + (size_t)row * 2048 + col); }
    __device__ __forceinline__ void put8p(int row, int col, f32x4 lo, f32x4 hi, const u32x4 (&d)[1]) const {
        f32x4 ga, gb; unpack8(d[0], ga, gb); ga = sig4(ga); gb = sig4(gb);
        *(u32x4*)(TMP + (size_t)row * D + col) = pack8(ga * lo, gb * hi);
    }
};
struct EpiQm {
    const bf16* G1; const bf16* TMP; bf16* MG;
    static constexpr int NLOAD = 2;
    __device__ __forceinline__ void pre(int row, int col, u32x4 (&d)[2]) const { d[0] = *(const u32x4*)(G1 + (size_t)row * 2048 + 1024 + col); d[1] = *(const u32x4*)(TMP + (size_t)row * D + col); }
    __device__ __forceinline__ void put8p(int row, int col, f32x4 lo, f32x4 hi, const u32x4 (&d)[2]) const {
        f32x4 ga, gb, ta, tb; unpack8(d[0], ga, gb); ga = sig4(ga); gb = sig4(gb); unpack8(d[1], ta, tb);
        *(u32x4*)(MG + (size_t)row * D + col) = pack8(ta + ga * lo, tb + gb * hi);
    }
};
struct EpiPMeta {
    const float* MPROJ; float* MTMP;
    __device__ __forceinline__ void put8(int t, int col, f32x4 lo, f32x4 hi) const {
        const f32x4 ga = sig4(*(const f32x4*)(MPROJ + (size_t)t * 4096 + 2048 + col)), gb = sig4(*(const f32x4*)(MPROJ + (size_t)t * 4096 + 2048 + col + 4));
        *(f32x4*)(MTMP + (size_t)t * D + col) = ga * lo; *(f32x4*)(MTMP + (size_t)t * D + col + 4) = gb * hi;
    }
};
struct EpiQMeta {
    const float* MPROJ; const float* MTMP; bf16* MMERG;
    __device__ __forceinline__ void put8(int t, int col, f32x4 lo, f32x4 hi) const {
        const f32x4 ga = sig4(*(const f32x4*)(MPROJ + (size_t)t * 4096 + 3072 + col)), gb = sig4(*(const f32x4*)(MPROJ + (size_t)t * 4096 + 3072 + col + 4));
        const f32x4 ta = *(const f32x4*)(MTMP + (size_t)t * D + col), tb = *(const f32x4*)(MTMP + (size_t)t * D + col + 4);
        *(u32x4*)(MMERG + (size_t)t * D + col) = pack8(ta + ga * lo, tb + gb * hi);
    }
};
struct EpiRes {
    const float* res; float* out;
    __device__ __forceinline__ void put8(int row, int col, f32x4 lo, f32x4 hi) const {
        const f32x4 ra = *(const f32x4*)(res + (size_t)row * D + col), rb = *(const f32x4*)(res + (size_t)row * D + col + 4);
        *(f32x4*)(out + (size_t)row * D + col) = ra + lo; *(f32x4*)(out + (size_t)row * D + col + 4) = rb + hi;
    }
};
struct EpiResX {
    const float* res; bf16* out;
    static constexpr int NLOAD = 2;
    __device__ __forceinline__ void pre(int row, int col, u32x4 (&d)[2]) const { d[0] = *(const u32x4*)(res + (size_t)row * D + col); d[1] = *(const u32x4*)(res + (size_t)row * D + col + 4); }
    __device__ __forceinline__ void put8p(int row, int col, f32x4 lo, f32x4 hi, const u32x4 (&d)[2]) const {
        const f32x4 ra = __builtin_bit_cast(f32x4, d[0]), rb = __builtin_bit_cast(f32x4, d[1]);
        *(u32x4*)(out + (size_t)row * D + col) = pack8(ra + lo, rb + hi);
    }
};
struct EpiResH {
    bf16* h;
    static constexpr int NLOAD = 1;
    __device__ __forceinline__ void pre(int row, int col, u32x4 (&d)[1]) const { d[0] = *(const u32x4*)(h + (size_t)row * D + col); }
    __device__ __forceinline__ void put8p(int row, int col, f32x4 lo, f32x4 hi, const u32x4 (&d)[1]) const {
        f32x4 ra, rb; unpack8(d[0], ra, rb);
        *(u32x4*)(h + (size_t)row * D + col) = pack8(ra + lo, rb + hi);
    }
};
__device__ __forceinline__ f32x4 swiglu4(f32x4 g, f32x4 u) { return (f32x4){g[0] * sigmoidf_(g[0]) * u[0], g[1] * sigmoidf_(g[1]) * u[1], g[2] * sigmoidf_(g[2]) * u[2], g[3] * sigmoidf_(g[3]) * u[3]}; }
struct EpiGU {
    bf16* ACT; int row_off;
    __device__ __forceinline__ void put8x2(int row, int col, f32x4 g0, f32x4 g1, f32x4 u0, f32x4 u1) const {
        *(u32x4*)(ACT + (size_t)(row - row_off) * DFF + col) = pack8(swiglu4(g0, u0), swiglu4(g1, u1));
    }
};
struct EpiY {
    bf16* Y;
    __device__ __forceinline__ void put8(int row, int col, f32x4 lo, f32x4 hi) const { *(u32x4*)(Y + (size_t)row * D + col) = pack8(lo, hi); }
};


template <class E, class = void> struct epi_nload { static constexpr int v = 0; };
template <class E> struct epi_nload<E, decltype((void)E::NLOAD)> { static constexpr int v = E::NLOAD; };
template <int MODE, class E> struct PgEpi {
    static constexpr bool PERM = (MODE != 2), AFTER_DRAIN = false;
    E e;
    __device__ __forceinline__ void operator()(const f32x4 (&acc)[2][2][4][2], const pg8::Unit& u, int wr, int wc, int fr, int fq) const {
        { const int le = lane_id_fresh(); fr = le & 15; fq = le >> 4; }
        if constexpr (MODE == 0 && epi_nload<E>::v > 0) {
            constexpr int NL = epi_nload<E>::v;
            u32x4 pre[2][4][NL];
            const int row00 = u.po * 256 + wr * 64 + fr, col00 = u.pn * 256 + wc * 32 + 8 * fq;
#pragma unroll
            for (int j = 0; j < 4; ++j) e.pre(row00 + (j >> 3) * 128 + ((j >> 1) & 3) * 16, col00 + (j & 1) * 128, pre[0][j]);
#pragma unroll
            for (int g = 0; g < 4; ++g) {
                if (g + 1 < 4) {
#pragma unroll
                    for (int j = 0; j < 4; ++j) { const int idx = 4 * (g + 1) + j; e.pre(row00 + (idx >> 3) * 128 + ((idx >> 1) & 3) * 16, col00 + (idx & 1) * 128, pre[(g + 1) & 1][j]); } }
                __builtin_amdgcn_sched_barrier(0);
#pragma unroll
                for (int j = 0; j < 4; ++j) { const int idx = 4 * g + j; e.put8p(row00 + (idx >> 3) * 128 + ((idx >> 1) & 3) * 16, col00 + (idx & 1) * 128, acc[idx >> 3][idx & 1][(idx >> 1) & 3][0], acc[idx >> 3][idx & 1][(idx >> 1) & 3][1], pre[g & 1][j]); }
                __builtin_amdgcn_sched_barrier(0);
            }
        } else
#pragma unroll
        for (int ai = 0; ai < 2; ++ai)
#pragma unroll
            for (int m = 0; m < 4; ++m) {
                if constexpr (MODE == 0) { const int row = u.po * 256 + ai * 128 + wr * 64 + m * 16 + fr;
#pragma unroll
                    for (int bj = 0; bj < 2; ++bj) e.put8(row, u.pn * 256 + bj * 128 + wc * 32 + 8 * fq, acc[ai][bj][m][0], acc[ai][bj][m][1]); }
                else if constexpr (MODE == 1) { const int row = u.po * 256 + ai * 128 + wr * 64 + m * 16 + fr;
                    e.put8x2(row, u.pn * 128 + wc * 32 + 8 * fq, acc[ai][0][m][0], acc[ai][0][m][1], acc[ai][1][m][0], acc[ai][1][m][1]); }
                else { const int row0 = u.po * 256 + ai * 128 + wr * 64 + m * 16 + 4 * fq;
#pragma unroll
                    for (int bj = 0; bj < 2; ++bj)
#pragma unroll
                        for (int n = 0; n < 2; ++n) e.putT(row0, u.pn * 256 + bj * 128 + wc * 32 + 16 * n + fr, acc[ai][bj][m][n]); }
            }
    }
};
constexpr int MOE_DOWN_FULL = 4;
struct MoeOrder {
    pg8::StaticOrder so; int p0; const int* PE; int nbt; int a_abs;
    int imin = 0, imax = 1 << 30;
    __device__ __forceinline__ bool next(int i, pg8::Unit& u) const {
        if (i + imin >= imax || !so.next(i + imin, u)) return false;
        const int rel = u.pm, e = __builtin_amdgcn_readfirstlane(PE[p0 + rel]); u.pb = e * nbt + u.pn; u.pm = a_abs ? p0 + rel : rel; u.po = a_abs ? rel : p0 + rel; return true; }
    __device__ __forceinline__ void a_ready(const pg8::Unit&) const {}
    __device__ __forceinline__ void done(const pg8::Unit&) const {}
};
template <int MODE, class E, class Sched, bool F8 = false>
__device__ __forceinline__ void pg_gemm(const Frame& F, const bf16* A, const bf16* Bt, int K, const Sched& S, const E& e) {
    pg8::Gemm g{A, Bt, 0, 0, K}; PgEpi<MODE, E> pe{e};
    pg8::gemm_phase<PgEpi<MODE, E>, Sched, true, true, MODE == 2, F8>(F.lds, g, S, pe, F.tid);
}

__device__ __forceinline__ void tr_item(const float* __restrict__ W, int ldw, int col0, int K, int ncols, bf16* WT, int row0, int gu, LAS float* scr, int item, int lane) {
    const int nblk = ncols / 32, kb = item / nblk, nb = item % nblk, k0 = 64 * kb, n0 = 32 * nb;
    float wv[32];
#pragma unroll
    for (int i = 0; i < 32; ++i) { const int kk = 2 * i + (lane >> 5); wv[i] = W[(size_t)(k0 + kk) * ldw + col0 + n0 + (lane & 31)]; }
#pragma unroll
    for (int i = 0; i < 32; ++i) { const int kk = 2 * i + (lane >> 5); scr[kk * 33 + (lane & 31)] = wv[i]; }
    LDS_WAIT(); asm volatile("" ::: "memory");
    const int drow0 = gu ? (256 * (n0 >> 7) + (n0 & 127) + row0) : (row0 + n0);
    const int c = lane & 7;
#pragma unroll
    for (int j = 0; j < 4; ++j) { const int n = (lane >> 3) + 8 * j; const LAS float* s = scr + (8 * c) * 33 + n;
        u32x4 o; o.x = cvtpk(s[0 * 33], s[1 * 33]); o.y = cvtpk(s[2 * 33], s[3 * 33]); o.z = cvtpk(s[4 * 33], s[5 * 33]); o.w = cvtpk(s[6 * 33], s[7 * 33]);
        *(u32x4*)(WT + (size_t)(drow0 + n) * K + k0 + 8 * c) = o; }
    LDS_WAIT(); asm volatile("" ::: "memory");
}
__device__ __forceinline__ void tr_item8(const float* __restrict__ W, int ldw, int K, int ncols, unsigned char* WT, int row0, int gu, LAS float* scr, int item, int lane, float sc) {
    const int nblk = ncols / 32, kb = item / nblk, nb = item % nblk, k0 = 64 * kb, n0 = 32 * nb;
    float wv[32];
#pragma unroll
    for (int i = 0; i < 32; ++i) { const int kk = 2 * i + (lane >> 5); wv[i] = W[(size_t)(k0 + kk) * ldw + n0 + (lane & 31)]; }
#pragma unroll
    for (int i = 0; i < 32; ++i) { const int kk = 2 * i + (lane >> 5); scr[kk * 33 + (lane & 31)] = wv[i] * sc; }
    LDS_WAIT(); asm volatile("" ::: "memory");
    const int drow0 = gu ? (256 * (n0 >> 7) + (n0 & 127) + row0) : (row0 + n0);
    const int c = lane & 7;
#pragma unroll
    for (int j = 0; j < 4; ++j) { const int n = (lane >> 3) + 8 * j; const LAS float* s = scr + (8 * c) * 33 + n;
        u32x2 o; o.x = pk4_fp8(s[0 * 33], s[1 * 33], s[2 * 33], s[3 * 33]); o.y = pk4_fp8(s[4 * 33], s[5 * 33], s[6 * 33], s[7 * 33]);
        *(u32x2*)(WT + (size_t)(drow0 + n) * K + k0 + 8 * c) = o; }
    LDS_WAIT(); asm volatile("" ::: "memory");
}
__device__ __forceinline__ float row_rs(const f32x4 (&v)[4]) {
    float s = 0.f;
#pragma unroll
    for (int j = 0; j < 4; ++j) s += (v[j][0] * v[j][0] + v[j][1] * v[j][1]) + (v[j][2] * v[j][2] + v[j][3] * v[j][3]);
    return 1.0f / sqrtf(wave_sum(s) * (1.0f / D) + RMS_EPS);
}
__device__ __forceinline__ int rowcol(int lane, int j) { return ((j >> 1) << 9) + 8 * lane + 4 * (j & 1); }
__device__ __forceinline__ void load_row_b(const bf16* src, int lane, f32x4 (&v)[4]) { unpack8(*(const u32x4*)(src + 8 * lane), v[0], v[1]); unpack8(*(const u32x4*)(src + 512 + 8 * lane), v[2], v[3]); }
__device__ __forceinline__ void norm_row_b(const bf16* src, const float* gain, bf16* dst, int lane) {
    f32x4 v[4]; load_row_b(src, lane, v);
    const float rs = row_rs(v);
    f32x4 o[4];
#pragma unroll
    for (int j = 0; j < 4; ++j) o[j] = v[j] * rs * *(const f32x4*)(gain + rowcol(lane, j));
    *(u32x4*)(dst + 8 * lane) = pack8(o[0], o[1]); *(u32x4*)(dst + 512 + 8 * lane) = pack8(o[2], o[3]);
}
__device__ __forceinline__ void norm_row(const float* src, const float* gain, bf16* dst, int lane) {
    const f32x4* xr = (const f32x4*)src + lane; f32x4 v[4];
#pragma unroll
    for (int j = 0; j < 4; ++j) v[j] = xr[64 * j];
    const float rs = row_rs(v);
#pragma unroll
    for (int j = 0; j < 4; ++j) { const f32x4 g = ((const f32x4*)gain)[lane + 64 * j]; const f32x4 o = v[j] * rs * g; u32x2 w; w.x = cvtpk(o[0], o[1]); w.y = cvtpk(o[2], o[3]); *((u32x2*)dst + lane + 64 * j) = w; }
}
__device__ __forceinline__ void zero_meta_tiles(const Frame& F) {
    bf16* Kb = (bf16*)(F.ws + WS_K); bf16* VT = (bf16*)(F.ws + WS_VT);
    const int gt = F.blk * NTHR + F.tid, NT = F.G * NTHR;
    unsigned zz = 0u; asm volatile("" : "+v"(zz)); const u32x4 z = (u32x4){zz, zz, zz, zz};
    for (int i = gt; i < NB * NH * 2 * 512; i += NT) { const int t = i >> 9, o = i & 511; *(u32x4*)(Kb + (size_t)t * KROWS * 64 + o * 8) = z; }
    for (int i = gt; i < NB * NH * 128 * 8; i += NT) { const int r = i >> 3, o = i & 7; *(u32x4*)(VT + (size_t)r * KROWS + o * 8) = z; }
}
__device__ __forceinline__ float lambda_init(int layer) { return layer == 0 ? 0.2f : 0.35550906f; }

struct TrSrc { const float* W; int ldw, col0, K, ncols, row0, gu; void* WT; };
__device__ __forceinline__ void tr_load(const TrSrc& s, int item, int lane, float (&wv)[32]) {
    const int nblk = s.ncols / 32, kb = item / nblk, nb = item % nblk, k0 = 64 * kb, n0 = 32 * nb;
    const float* p = s.W + (size_t)(k0 + (lane >> 5)) * s.ldw + s.col0 + n0 + (lane & 31);
#pragma unroll
    for (int i = 0; i < 32; ++i) wv[i] = p[(size_t)(2 * i) * s.ldw];
}
template <bool F8> __device__ __forceinline__ void tr_store(const TrSrc& s, int item, int lane, const float (&wv)[32], LAS float* scr, float sc) {
    const int nblk = s.ncols / 32, kb = item / nblk, nb = item % nblk, k0 = 64 * kb, n0 = 32 * nb, K = s.K;
#pragma unroll
    for (int i = 0; i < 32; ++i) { const int kk = 2 * i + (lane >> 5); scr[kk * 33 + (lane & 31)] = F8 ? wv[i] * sc : wv[i]; }
    LDS_WAIT(); asm volatile("" ::: "memory");
    const int drow0 = s.gu ? (256 * (n0 >> 7) + (n0 & 127) + s.row0) : (s.row0 + n0);
    const int c = lane & 7;
#pragma unroll
    for (int j = 0; j < 4; ++j) { const int n = (lane >> 3) + 8 * j; const LAS float* q = scr + (8 * c) * 33 + n;
        if constexpr (F8) { u32x2 o; o.x = pk4_fp8(q[0 * 33], q[1 * 33], q[2 * 33], q[3 * 33]); o.y = pk4_fp8(q[4 * 33], q[5 * 33], q[6 * 33], q[7 * 33]);
            *(u32x2*)((unsigned char*)s.WT + (size_t)(drow0 + n) * K + k0 + 8 * c) = o; }
        else { u32x4 o; o.x = cvtpk(q[0 * 33], q[1 * 33]); o.y = cvtpk(q[2 * 33], q[3 * 33]); o.z = cvtpk(q[4 * 33], q[5 * 33]); o.w = cvtpk(q[6 * 33], q[7 * 33]);
            *(u32x4*)((bf16*)s.WT + (size_t)(drow0 + n) * K + k0 + 8 * c) = o; } }
    LDS_WAIT(); asm volatile("" ::: "memory");
}
__device__ __forceinline__ void ph_prologue(const Frame& F0, KArgs a) {
    const Frame F = relaunder(F0);
    LAS float* scr = (LAS float*)(F.lds + F.wave * 16384);
    constexpr int J1 = 16 * 48, J2 = 16 * 64, J3 = 16 * 16, J4 = 8 * 32, J5 = 16 * 32, JL = J1 + J2 + J3 + J4 + J5;
    constexpr int J6 = 16 * 112, J8 = 56 * 32, JWC = 1024;
    constexpr int NJ = 2 * JL + 2 * J6 + J8 + 2 * JWC;
    bf16* HN = (bf16*)(F.ws + WS_HN);
    f32x4 gx[4];
#pragma unroll
    for (int j = 0; j < 4; ++j) gx[j] = ((const f32x4*)a->in[I_NMIX])[F.lane + 64 * j];
    const f32x4* x0 = (const f32x4*)a->in[I_X] + F.lane; f32x4 cur[4];
#pragma unroll
    for (int j = 0; j < 4; ++j) cur[j] = x0[(size_t)F.gw * 256 + 64 * j];
    int nm_ = F.gw;
    auto norm_rows = [&](int cnt) {
#pragma unroll 1
        for (int q = 0; q < cnt && nm_ < M; ++q) { const int m = nm_; const int nm = (m + F.NGW < M) ? m + F.NGW : m; f32x4 nxt[4];
#pragma unroll
            for (int j = 0; j < 4; ++j) nxt[j] = x0[(size_t)nm * 256 + 64 * j];
            const float rs = row_rs(cur); bf16* dst = HN + (size_t)m * D;
#pragma unroll
            for (int j = 0; j < 4; ++j) { const f32x4 o = cur[j] * rs * gx[j]; u32x2 w; w.x = cvtpk(o[0], o[1]); w.y = cvtpk(o[2], o[3]); *((u32x2*)dst + F.lane + 64 * j) = w; cur[j] = nxt[j]; }
            nm_ += F.NGW; } };
    constexpr int NJT = 2 * JL + 2 * J6 + J8;
#pragma unroll 1
    for (int it = F.gw; it < NJT; it += F.NGW) {
        int r = it; TrSrc t; t.gu = 0; t.row0 = 0; t.col0 = 0;
        if (r < 2 * JL) { const int l = r / JL; r %= JL;
            const float* win = a->in[I_WIN] + (size_t)l * D * 4096;
            if (r < J1) { t.W = win; t.ldw = 4096; t.K = D; t.ncols = 1536; t.WT = F.ws + WS_WIN + l * WIN_L; }
            else if (r < J1 + J2) { r -= J1; t.W = win; t.ldw = 4096; t.col0 = 2048; t.K = D; t.ncols = 2048; t.WT = F.ws + WS_WIN + l * WIN_L; t.row0 = 1536; }
            else if (r < J1 + J2 + J3) { r -= J1 + J2; t.W = win; t.ldw = 4096; t.col0 = 1536; t.K = D; t.ncols = 512; t.WT = F.ws + WS_WV + l * WV_L; }
            else if (r < J1 + J2 + J3 + J4) { r -= J1 + J2 + J3; t.W = a->in[I_WAU] + (size_t)l * 512 * D; t.ldw = D; t.K = 512; t.ncols = D; t.WT = F.ws + WS_WAU + l * WC_L; }
            else { r -= J1 + J2 + J3 + J4; t.W = a->in[I_WOUT] + (size_t)l * D * D; t.ldw = D; t.K = D; t.ncols = D; t.WT = F.ws + WS_WOUT + l * WOUT_L; } }
        else { r -= 2 * JL;
            if (r < J6) { t.W = a->in[I_DG]; t.ldw = DFF; t.K = D; t.ncols = DFF; t.WT = F.ws + WS_WGU; t.gu = 1; }
            else if (r < 2 * J6) { r -= J6; t.W = a->in[I_DU]; t.ldw = DFF; t.K = D; t.ncols = DFF; t.WT = F.ws + WS_WGU; t.row0 = 128; t.gu = 1; }
            else { r -= 2 * J6; t.W = a->in[I_DD]; t.ldw = D; t.K = DFF; t.ncols = D; t.WT = F.ws + WS_WD; } }
        float wv[32]; tr_load(t, r, F.lane, wv);
        norm_rows(3);
        tr_store<false>(t, r, F.lane, wv, scr, 1.0f);
    }
#pragma unroll 1
    for (int it = F.gw; it < 2 * JWC; it += F.NGW) {
        int r = it;
        {
            const int l = r / JWC; r %= JWC; const int g = r >> 8, cch = (r >> 4) & 15, nb = r & 15; const int n = nb * 64 + F.lane, c0 = cch * 8;
            const float* Wg = a->in[I_PGW] + ((size_t)(l * 4 + g) * 128 + c0) * 128; const float* sc = a->in[I_PSC] + l * 512 + g * 128; const float* Wpu = a->in[I_WPU] + ((size_t)l * 512 + g * 128) * D + n;
            float acc[8];
#pragma unroll
            for (int j = 0; j < 8; ++j) acc[j] = 0.f;
#pragma unroll 16
            for (int d = 0; d < 128; ++d) { const float w = Wpu[(size_t)d * D] * sc[d];
#pragma unroll
                for (int j = 0; j < 8; ++j) acc[j] += Wg[j * 128 + d] * w; }
            u32x4 o; o.x = cvtpk(acc[0], acc[1]); o.y = cvtpk(acc[2], acc[3]); o.z = cvtpk(acc[4], acc[5]); o.w = cvtpk(acc[6], acc[7]);
            *(u32x4*)((bf16*)(F.ws + WS_WC + l * WC_L) + (size_t)n * 512 + g * 128 + c0) = o;
        }
    }
    norm_rows(M);
    for (int t = F.gw; t < NMETA; t += F.NGW) {
        norm_row(a->in[I_META] + (size_t)t * D, a->in[I_NMIX], (bf16*)(F.ws + SM_MHN) + (size_t)t * D, F.lane);
        float* MH = (float*)(F.ws + SM_MH) + (size_t)t * D; const f32x4* xr = (const f32x4*)(a->in[I_META] + (size_t)t * D) + F.lane;
#pragma unroll
        for (int j = 0; j < 4; ++j) ((f32x4*)MH)[F.lane + 64 * j] = xr[64 * j];
    }
    zero_meta_tiles(F);
}

__device__ __forceinline__ void ph_norm(const Frame& F0, int which) {
    const Frame F = relaunder(F0); KArgs a = kargs();
    const bf16* src = (const bf16*)(F.ws + WS_H); const float* gain = which ? a->in[I_NMIX] + D : a->in[I_NFFN];
    bf16* HN = (bf16*)(F.ws + WS_HN);
    {   f32x4 g[4];
#pragma unroll
        for (int j = 0; j < 4; ++j) g[j] = *(const f32x4*)(gain + rowcol(F.lane, j));
        const bf16* s0 = src + 8 * F.lane; u32x4 ca = *(const u32x4*)(s0 + (size_t)F.gw * D), cb = *(const u32x4*)(s0 + (size_t)F.gw * D + 512);
#pragma unroll 1
        for (int m = F.gw; m < M; m += F.NGW) { const int nm = (m + F.NGW < M) ? m + F.NGW : m;
            const u32x4 na = *(const u32x4*)(s0 + (size_t)nm * D), nb = *(const u32x4*)(s0 + (size_t)nm * D + 512);
            f32x4 v[4]; unpack8(ca, v[0], v[1]); unpack8(cb, v[2], v[3]);
            const float rs = row_rs(v); bf16* dst = HN + (size_t)m * D;
            *(u32x4*)(dst + 8 * F.lane) = pack8(v[0] * rs * g[0], v[1] * rs * g[1]); *(u32x4*)(dst + 512 + 8 * F.lane) = pack8(v[2] * rs * g[2], v[3] * rs * g[3]);
            ca = na; cb = nb; }
    }
    for (int t = F.gw; t < NMETA; t += F.NGW) norm_row((const float*)(F.ws + SM_MH) + (size_t)t * D, gain, (bf16*)(F.ws + SM_MHN) + (size_t)t * D, F.lane);
    if (which) zero_meta_tiles(F);
}

__device__ __forceinline__ void ph_inproj(const Frame& F0, int l) {
    const Frame F = relaunder(F0);
    const bf16* HN = (const bf16*)(F.ws + WS_HN); const bf16* WIN = (const bf16*)(F.ws + WS_WIN + l * WIN_L); const bf16* WV = (const bf16*)(F.ws + WS_WV + l * WV_L);
    {
        EpiInProjMeta Em{(float*)(F.ws + SM_MPROJ), (bf16*)(F.ws + WS_K), (bf16*)(F.ws + WS_U)};
        g16_meta<0>(F, (const bf16*)(F.ws + SM_MHN), D, WIN, D, D, NIN / 32, Em);
        EpiVMeta Ev{(float*)(F.ws + SM_MPROJ), (bf16*)(F.ws + WS_VT)};
        if (F.blk >= 128) { Frame F2 = F; F2.blk = F.blk - 128; F2.G = 128; g16_meta<2>(F2, (const bf16*)(F.ws + SM_MHN), D, WV, D, D, 512 / 32, Ev); }
    }
    EpiInProj E{(bf16*)(F.ws + WS_U), (bf16*)(F.ws + WS_Q), (bf16*)(F.ws + WS_K), (bf16*)(F.ws + WS_G0), (bf16*)(F.ws + WS_G1)};
    EpiV EV{(bf16*)(F.ws + WS_VT)};
#if USE_PG8
    { pg8::StaticOrder So; So.init(M / 256, NIN / 256, F.G, F.blk); pg_gemm<0>(F, HN, WIN, D, So, E); }
    { pg8::StaticOrder So; So.init(M / 256, 512 / 256, F.G, F.blk); pg_gemm<2>(F, HN, WV, D, So, EV); }
#else
    g16_phase<0>(F, HN, D, WIN, D, D, M / 16, NIN / 32, E);
    g16_phase<2>(F, HN, D, WV, D, D, M / 16, 512 / 32, EV);
#endif
}

__device__ __forceinline__ void build_bias(const Frame& F, const float* relb, LAS float* tab) {
    if (F.tid < 512) { const int h = F.tid >> 7, n = F.tid & 127; tab[F.tid] = (relb[t5_bucket(n) * NH + h] - relb[31 * NH + h]) * LOG2E; }
}
__device__ __forceinline__ float layer_lambda(KArgs a, int l, int lane) {
    const float p1 = wave_sum(a->in[I_LQ1][l * 64 + lane] * a->in[I_LK1][l * 64 + lane]);
    const float p2 = wave_sum(a->in[I_LQ2][l * 64 + lane] * a->in[I_LK2][l * 64 + lane]);
    return expf(p1) - expf(p2) + lambda_init(l);
}

__device__ __forceinline__ void meta_mixers(const Frame& F, KArgs a, int l, float lam, const LAS float* biasp) {
    const float* MP = (const float*)(F.ws + SM_MPROJ);
    bf16* MMIX = (bf16*)(F.ws + SM_MMIX); bf16* MBOUT = (bf16*)(F.ws + SM_MBOUT);
    LAS float* QKV = (LAS float*)(F.lds + 4096);
    LAS float* Sc = (LAS float*)(F.lds + 4096 + 98304);
    LAS float* red = (LAS float*)(F.lds + 4096 + 98304 + 8192);
    { f32x4 v[12];
#pragma unroll
      for (int i = 0; i < 12; ++i) { const int idx = F.tid + NTHR * i; const int t = idx / 384, c4 = idx % 384; v[i] = *(const f32x4*)(MP + (size_t)t * 4096 + 512 + 4 * c4); }
#pragma unroll
      for (int i = 0; i < 12; ++i) { const int idx = F.tid + NTHR * i; ((LAS f32x4*)QKV)[idx] = v[i]; } }
#pragma unroll 1
    for (int idx = F.tid; idx < NMETA * 512; idx += NTHR) { const int t = idx >> 9, ch = idx & 511; const int w = 2 << (ch >> 7); const int cnt = (t + 1 < w) ? t + 1 : w;
        float uv[16];
#pragma unroll
        for (int j = 0; j < 16; ++j) uv[j] = (j < cnt) ? MP[(size_t)(t - j) * 4096 + ch] : 0.f;
        float s = 0.f;
#pragma unroll
        for (int j = 0; j < 16; ++j) s += uv[j];
        MMIX[idx] = f2bf(s / (float)cnt - uv[0]); }
    __syncthreads();
#pragma unroll 1
    for (int i = 0; i < 4; ++i) { const int idx = F.tid + NTHR * i; const int t2 = idx & 15, t = (idx >> 4) & 15, c = (idx >> 8) & 1, h = idx >> 9;
        float s = -INFINITY;
        if (t2 <= t) { const LAS f32x4* q = (const LAS f32x4*)(QKV + t * 1536 + h * 128 + c * 64); const LAS f32x4* k = (const LAS f32x4*)(QKV + t2 * 1536 + 512 + h * 128 + c * 64); float d = 0.f;
#pragma unroll
            for (int e = 0; e < 16; ++e) { const f32x4 x = q[e], y = k[e]; d += (x[0] * y[0] + x[1] * y[1]) + (x[2] * y[2] + x[3] * y[3]); }
            s = d * C2 + biasp[h * 128 + (t - t2)]; }
        Sc[idx] = s; }
    __syncthreads();
    if (F.tid < 128) { LAS float* r = Sc + F.tid * 16; float m = -INFINITY; for (int j = 0; j < 16; ++j) m = fmaxf(m, r[j]); float sum = 0.f; float p[16];
#pragma unroll
        for (int j = 0; j < 16; ++j) { p[j] = __builtin_amdgcn_exp2f(r[j] - m); sum += p[j]; }
        const float inv = 1.0f / sum;
#pragma unroll
        for (int j = 0; j < 16; ++j) r[j] = p[j] * inv; }
    __syncthreads();
    { const int h = F.tid >> 7, d = F.tid & 127; float o[16];
        const LAS float* vcol = QKV + 1024 + h * 128 + d;
#pragma unroll
        for (int t = 0; t < 16; ++t) { float acc = 0.f;
#pragma unroll
            for (int t2 = 0; t2 <= t; ++t2) acc += (Sc[((h * 2 + 0) * 16 + t) * 16 + t2] - lam * Sc[((h * 2 + 1) * 16 + t) * 16 + t2]) * vcol[t2 * 1536];
            o[t] = acc; const float ss = wave_sum(acc * acc); if (F.lane == 0) red[F.wave * 16 + t] = ss; }
        __syncthreads();
        const float gn = a->in[I_SUBLN][l * 128 + d] * (1.0f - lambda_init(l));
#pragma unroll
        for (int t = 0; t < 16; ++t) { const float ss = red[(2 * h) * 16 + t] + red[(2 * h + 1) * 16 + t];
            MBOUT[t * 512 + h * 128 + d] = f2bf(o[t] * (1.0f / sqrtf(ss * (1.0f / 128.0f) + SUBLN_EPS)) * gn); }
    }
    __syncthreads();
}

__device__ __forceinline__ void pool_main(const Frame& F) {
    const bf16* U = (const bf16*)(F.ws + WS_U); bf16* AMIX = (bf16*)(F.ws + WS_AMIX);
    const int ch = F.lane * 8, g = ch >> 7, w = 2 << g;
    const float inv = 1.0f / (float)w;
    for (int it = F.gw; it < M / 16; it += F.NGW) { const int r0 = it * 16, s0 = r0 & (S - 1), b = r0 >> 13;
        const bf16* up = U + ((size_t)b * UROWS + NMETA + s0 - 15) * 512 + ch;
        u32x4 raw[31];
#pragma unroll
        for (int i = 0; i < 31; ++i) raw[i] = *(const u32x4*)(up + (size_t)i * 512);
        const u32x4 z4 = (u32x4){0u, 0u, 0u, 0u};
        f32x4 sa = (f32x4){0.f, 0.f, 0.f, 0.f}, sb = sa;
#pragma unroll
        for (int j = 0; j < 16; ++j) { f32x4 a_, b_; unpack8((j < 2 || j < w) ? raw[15 - j] : z4, a_, b_); sa += a_; sb += b_; }
        bf16* dst = AMIX + (size_t)r0 * 512 + ch;
#pragma unroll
        for (int k = 0; k < 16; ++k) {
            f32x4 ua, ub; unpack8(raw[15 + k], ua, ub);
            if (k > 0) { const u32x4 old = (g == 0) ? raw[13 + k] : (g == 1) ? raw[11 + k] : (g == 2) ? raw[7 + k] : raw[k - 1];
                f32x4 oa, ob; unpack8(old, oa, ob); sa += ua - oa; sb += ub - ob; }
            *(u32x4*)(dst + (size_t)k * 512) = pack8(sa * inv - ua, sb * inv - ub);
        }
    }
}

__device__ __forceinline__ void attn_simple(const Frame& F, KArgs a, int l, float lam, const LAS float* biasp) {
    const bf16* Q = (const bf16*)(F.ws + WS_Q); const bf16* Kb = (const bf16*)(F.ws + WS_K); const bf16* VT = (const bf16*)(F.ws + WS_VT); bf16* ABOUT = (bf16*)(F.ws + WS_ABOUT);
    LAS float* Kl = (LAS float*)(F.lds + 16384);
    LAS float* Vl = (LAS float*)(F.lds + 16384 + 16384);
    const int qi = F.tid >> 2, dq = F.tid & 3;
    for (int item = F.blk; item < NB * NH * 64; item += F.G) {
        const int qb = 63 - (item >> 4), bh = item & 15, b = bh >> 2, h = bh & 3;
        const int s = qb * 128 + qi;
        LAS float* o1 = (LAS float*)(F.lds + 65536) + qi * 128 + dq * 32;
#pragma unroll 1
        for (int c = 0; c < 2; ++c) {
            float q[64];
            { const bf16* qp = Q + ((size_t)((bh * 2 + c)) * S + s) * 64;
#pragma unroll
                for (int e = 0; e < 8; ++e) { f32x4 x, y; unpack8(*(const u32x4*)(qp + 8 * e), x, y); q[8 * e + 0] = x[0]; q[8 * e + 1] = x[1]; q[8 * e + 2] = x[2]; q[8 * e + 3] = x[3]; q[8 * e + 4] = y[0]; q[8 * e + 5] = y[1]; q[8 * e + 6] = y[2]; q[8 * e + 7] = y[3]; } }
            float m = -1e30f, lsum = 0.f; float o[32];
#pragma unroll
            for (int e = 0; e < 32; ++e) o[e] = 0.f;
            const int ntiles = 1 + 2 * (qb + 1);
#pragma unroll 1
            for (int jt = 0; jt < ntiles; ++jt) {
                __syncthreads();
                {
                    const int key = F.tid >> 3, ck = F.tid & 7; f32x4 x, y; unpack8(*(const u32x4*)(Kb + ((size_t)(bh * 2 + c) * KROWS + 64 * jt + key) * 64 + 8 * ck), x, y);
                    *(LAS f32x4*)(Kl + key * 64 + 8 * ck) = x; *(LAS f32x4*)(Kl + key * 64 + 8 * ck + 4) = y;
#pragma unroll
                    for (int i2 = 0; i2 < 2; ++i2) { const int idx = F.tid + NTHR * i2; const int d = idx >> 3, cv = idx & 7; f32x4 vx, vy; unpack8(*(const u32x4*)(VT + ((size_t)(bh * 128 + d)) * KROWS + 64 * jt + 8 * cv), vx, vy);
                        float vv[8] = {vx[0], vx[1], vx[2], vx[3], vy[0], vy[1], vy[2], vy[3]};
#pragma unroll
                        for (int e = 0; e < 8; ++e) { const int p = 8 * cv + e; const int sg = (p >> 2) & 3; const int g4 = (sg == 1) ? 2 : (sg == 2) ? 1 : sg; const int key2 = (p & ~15) + 4 * g4 + (p & 3); Vl[key2 * 128 + d] = vv[e]; } }
                }
                __syncthreads();
                const int nk = (jt == 0) ? 16 : 64;
#pragma unroll 1
                for (int j = 0; j < nk; ++j) {
                    int n;
                    if (jt == 0) n = s + 16 - j; else { const int sk = 64 * (jt - 1) + j; n = s - sk; }
                    if (n < 0) continue;
                    float d0 = 0.f, d1 = 0.f; const LAS float* kr = Kl + j * 64;
#pragma unroll
                    for (int e = 0; e < 64; e += 8) { const f32x4 k0 = *(const LAS f32x4*)(kr + e), k1 = *(const LAS f32x4*)(kr + e + 4);
                        d0 += q[e] * k0[0] + q[e + 1] * k0[1] + q[e + 2] * k0[2] + q[e + 3] * k0[3]; d1 += q[e + 4] * k1[0] + q[e + 5] * k1[1] + q[e + 6] * k1[2] + q[e + 7] * k1[3]; }
                    const float sc = d0 + d1 + biasp[h * 128 + (n < 127 ? n : 127)];
                    if (sc > m) { const float corr = __builtin_amdgcn_exp2f(m - sc); lsum *= corr;
#pragma unroll
                        for (int e = 0; e < 32; ++e) o[e] *= corr;
                        m = sc; }
                    const float p = __builtin_amdgcn_exp2f(sc - m); lsum += p;
                    const LAS float* vr = Vl + j * 128 + dq * 32;
#pragma unroll
                    for (int e = 0; e < 32; e += 4) { const f32x4 v4 = *(const LAS f32x4*)(vr + e); o[e] += p * v4[0]; o[e + 1] += p * v4[1]; o[e + 2] += p * v4[2]; o[e + 3] += p * v4[3]; }
                }
            }
            const float inv = 1.0f / lsum;
            if (c == 0) {
#pragma unroll
                for (int e = 0; e < 32; ++e) o1[e] = o[e] * inv; }
            else {
                float ss = 0.f;
#pragma unroll
                for (int e = 0; e < 32; ++e) { o[e] = o1[e] - lam * (o[e] * inv); ss += o[e] * o[e]; }
                ss = xor1_add(ss); ss = xor2_add(ss);
                const float rs = 1.0f / sqrtf(ss * (1.0f / 128.0f) + SUBLN_EPS) * (1.0f - lambda_init(l));
                const float* gn = a->in[I_SUBLN] + l * 128 + dq * 32; bf16* dst = ABOUT + (size_t)(b * S + s) * 512 + h * 128 + dq * 32;
#pragma unroll
                for (int e = 0; e < 32; e += 8) { f32x4 x = (f32x4){o[e] * rs * gn[e], o[e + 1] * rs * gn[e + 1], o[e + 2] * rs * gn[e + 2], o[e + 3] * rs * gn[e + 3]};
                    f32x4 y = (f32x4){o[e + 4] * rs * gn[e + 4], o[e + 5] * rs * gn[e + 5], o[e + 6] * rs * gn[e + 6], o[e + 7] * rs * gn[e + 7]}; *(u32x4*)(dst + e) = pack8(x, y); }
            }
        }
    }
}


typedef float f32x16 __attribute__((ext_vector_type(16)));
__device__ __forceinline__ void glds_r(const void* sbase, unsigned voff, unsigned ldsaddr) {
    asm volatile("s_mov_b32 m0, %2\n\ts_nop 0\n\tglobal_load_lds_dwordx4 %0, %1" :: "v"(voff), "s"(sbase), "s"(ldsaddr) : "memory", "m0"); }
__device__ __forceinline__ int crow(int r, int hi) { return (r & 3) + 8 * (r >> 2) + 4 * hi; }
constexpr int AT_KT = 8 * 1040, AT_VT = 8 * 2064;
constexpr float AT_THR = 8.0f;
__device__ __forceinline__ float xor16_add(float v) { return v + __builtin_bit_cast(float, __builtin_amdgcn_ds_swizzle(__builtin_bit_cast(int, v), 0x401F)); }
__device__ __forceinline__ float half_max(float m) { auto rr = __builtin_amdgcn_permlane32_swap(__builtin_bit_cast(unsigned, m), __builtin_bit_cast(unsigned, m), false, false); return fmaxf(__builtin_bit_cast(float, rr[0]), __builtin_bit_cast(float, rr[1])); }
#define AT_SBAR() __builtin_amdgcn_sched_barrier(0)
#define AT_PIN(x) asm volatile("" : "+v"(x))
#define AT_MFMA(a, b, c) __builtin_amdgcn_mfma_f32_32x32x16_bf16(a, b, c, 0, 0, 0)
constexpr int AT_VTN = 516;
struct AtC {
    const bf16* kgs; const bf16* vgs; unsigned kvo, vvo0, vvo1, ldsK, ldsV;
    const LAS unsigned char* tilesK; const LAS unsigned char* tilesV; unsigned kfo, vfo;
    const LAS float* vt4; LAS float* wsf; int s0w, r32, hi; };
template <int WN> __device__ __forceinline__ void at_waitbar() {
    if constexpr (WN == 4) asm volatile("s_waitcnt vmcnt(4) lgkmcnt(0)\n\ts_barrier" ::: "memory");
    else if constexpr (WN == 3) asm volatile("s_waitcnt vmcnt(3) lgkmcnt(0)\n\ts_barrier" ::: "memory");
    else if constexpr (WN == 2) asm volatile("s_waitcnt vmcnt(2) lgkmcnt(0)\n\ts_barrier" ::: "memory");
    else if constexpr (WN == 0) asm volatile("s_waitcnt vmcnt(0) lgkmcnt(0)\n\ts_barrier" ::: "memory");
}
template <bool META> __device__ __forceinline__ void at_bias(const AtC& X, int kbase, f32x16& p0, f32x16& p1) {
    int nbc = X.s0w + X.r32 - kbase; nbc = nbc > 200 ? 200 : nbc;
    int a0 = 255 - nbc + 4 * X.hi; asm volatile("" : "+v"(a0));
    const LAS float* tp = X.vt4 + (a0 & 3) * AT_VTN + (a0 & ~3);
    { f32x4 bq[4];
#pragma unroll
      for (int g = 0; g < 4; ++g) bq[g] = *(const LAS f32x4*)(tp + 8 * g);
#pragma unroll
      for (int g = 0; g < 4; ++g)
#pragma unroll
          for (int j = 0; j < 4; ++j) { if constexpr (META) p0[4 * g + j] += (g < 2) ? bq[g][j] : -INFINITY; else p0[4 * g + j] += bq[g][j]; } }
    { f32x4 bq[4];
#pragma unroll
      for (int g = 0; g < 4; ++g) bq[g] = *(const LAS f32x4*)(tp + 32 + 8 * g);
#pragma unroll
      for (int g = 0; g < 4; ++g)
#pragma unroll
          for (int j = 0; j < 4; ++j) { if constexpr (META) p1[4 * g + j] = -INFINITY; else p1[4 * g + j] += bq[g][j]; } }
}
__device__ __forceinline__ float at_rowmax(const f32x16& p0, const f32x16& p1) {
    float rm = fmaxf(fmaxf(p0[0], p0[1]), p1[0]);
#pragma unroll
    for (int r = 2; r < 16; r += 2) rm = fmaxf(fmaxf(rm, p0[r]), p0[r + 1]);
#pragma unroll
    for (int r = 1; r < 15; r += 2) rm = fmaxf(fmaxf(rm, p1[r]), p1[r + 1]);
    rm = fmaxf(rm, p1[15]);
    return half_max(rm);
}
template <bool GK, bool GV, bool GL, int WN>
__device__ __forceinline__ void at_step(const AtC& X, const int t, int& ks_cur, int& vs_prev, f32x16& C0, f32x16& C1, f32x16& P0, f32x16& P1,
                                        bf16x8 (&kf)[8], const bf16x8 (&qr)[4], f32x16 (&o)[4], float& mhat, float& lsum) {
    AT_SBAR();
    const f32x16 zero16 = {0.f, 0.f, 0.f, 0.f, 0.f, 0.f, 0.f, 0.f, 0.f, 0.f, 0.f, 0.f, 0.f, 0.f, 0.f, 0.f};
    const LAS unsigned char* vp = X.tilesV + vs_prev * AT_VT + X.vfo;
    const int ks_next = (ks_cur == 2) ? 0 : ks_cur + 1;
    const LAS unsigned char* ktn = X.tilesK + ks_next * AT_KT + X.kfo;
    bf16x8 vf[8]; u32x4 pw0, pw1, pw2, pw3;
    const unsigned lv_ = (unsigned)__builtin_amdgcn_readfirstlane((int)(X.ldsV + (unsigned)((vs_prev + 3) & 3) * AT_VT));
    f32x2 sacc2 = (f32x2){P0[0], P0[1]};
#define AT_VRD(m) vf[(m) & 7] = *(const LAS bf16x8*)(vp + ((m) >> 2) * 4128 + ((m) & 3) * 512)
#define AT_GAPA(m, MF, a0, a1, a2, a3, W0, W1, PW) do { AT_VRD(m); AT_SBAR(); MF; sacc2 += (f32x2){a0, a1}; sacc2 += (f32x2){a2, a3}; W0; W1; AT_PIN(PW); AT_PIN(sacc2); AT_SBAR(); } while (0)
    AT_GAPA(0, C0 = AT_MFMA(kf[0], qr[0], zero16), P0[2], P0[3], P0[4], P0[5],     pw0[0] = cvtpk(P0[0], P0[1]),   pw0[1] = cvtpk(P0[2], P0[3]),   pw0);
    AT_GAPA(1, C1 = AT_MFMA(kf[1], qr[0], zero16), P0[6], P0[7], P0[8], P0[9],     pw0[2] = cvtpk(P0[4], P0[5]),   pw0[3] = cvtpk(P0[6], P0[7]),   pw0);
    if constexpr (GK) { glds_r(X.kgs + (size_t)(t + 3) * 4096, X.kvo, (unsigned)__builtin_amdgcn_readfirstlane((int)(X.ldsK + (unsigned)ks_cur * AT_KT))); AT_SBAR(); }
    AT_GAPA(2, C0 = AT_MFMA(kf[2], qr[1], C0),   P0[10], P0[11], P0[12], P0[13], pw1[0] = cvtpk(P0[8], P0[9]),   pw1[1] = cvtpk(P0[10], P0[11]), pw1);
    AT_GAPA(3, C1 = AT_MFMA(kf[3], qr[1], C1),   P0[14], P0[15], P1[0], P1[1],   pw1[2] = cvtpk(P0[12], P0[13]), pw1[3] = cvtpk(P0[14], P0[15]), pw1);
    if constexpr (GV) { glds_r(X.vgs + (t + 2) * 64, X.vvo0, lv_); AT_SBAR(); }
    AT_GAPA(4, C0 = AT_MFMA(kf[4], qr[2], C0),   P1[2], P1[3], P1[4], P1[5],     pw2[0] = cvtpk(P1[0], P1[1]),   pw2[1] = cvtpk(P1[2], P1[3]),   pw2);
    AT_GAPA(5, C1 = AT_MFMA(kf[5], qr[2], C1),   P1[6], P1[7], P1[8], P1[9],     pw2[2] = cvtpk(P1[4], P1[5]),   pw2[3] = cvtpk(P1[6], P1[7]),   pw2);
    if constexpr (GV) { glds_r(X.vgs + (t + 2) * 64, X.vvo1, lv_ + 1024u); AT_SBAR(); }
    AT_GAPA(6, C0 = AT_MFMA(kf[6], qr[3], C0),   P1[10], P1[11], P1[12], P1[13], pw3[0] = cvtpk(P1[8], P1[9]),   pw3[1] = cvtpk(P1[10], P1[11]), pw3);
    AT_GAPA(7, C1 = AT_MFMA(kf[7], qr[3], C1),   P1[14], P1[15], 0.f, 0.f,       pw3[2] = cvtpk(P1[12], P1[13]), pw3[3] = cvtpk(P1[14], P1[15]), pw3);
    lsum += sacc2[0] + sacc2[1];
    const int kbase = 64 * (t - 1);
    if (X.s0w - (kbase + 63) < 113) at_bias<false>(X, kbase, C0, C1);
    const float rm = at_rowmax(C0, C1) - mhat;
    bool resc = false;
    if (__any(rm > AT_THR)) {
        const float dl = fmaxf(rm, 0.f); mhat += dl;
        const float f = __builtin_amdgcn_exp2f(-dl); lsum *= f;
        if (X.hi == 0) X.wsf[X.r32] = f;
        resc = true;
    }
    const f32x2 mh2 = (f32x2){mhat, mhat};
    AT_SBAR();
#define AT_PAF(k) __builtin_bit_cast(bf16x8, pw##k)
#define AT_GAPB(m, PK, CX, e) do { o[(m) & 3] = AT_MFMA(AT_PAF(PK), vf[(m) & 7], o[(m) & 3]); \
        if ((m) < 8) AT_VRD((m) + 8); \
        if (GL && (m) >= 4 && (m) < 12) kf[((m) - 4) & 7] = *(const LAS bf16x8*)(ktn + ((((m) - 4) & 7) >> 1) * 2080 + (((m) - 4) & 1) * 512); \
        { const f32x2 x_ = (f32x2){CX[e], CX[(e) + 1]} - mh2; CX[e] = __builtin_amdgcn_exp2f(x_[0]); CX[(e) + 1] = __builtin_amdgcn_exp2f(x_[1]); } AT_PIN(CX); AT_SBAR(); } while (0)
    AT_GAPB(0, 0, C0, 0);  AT_GAPB(1, 0, C0, 2);   AT_GAPB(2, 0, C0, 4);   AT_GAPB(3, 0, C0, 6);
    AT_GAPB(4, 1, C0, 8);  AT_GAPB(5, 1, C0, 10);  AT_GAPB(6, 1, C0, 12);  AT_GAPB(7, 1, C0, 14);
    AT_GAPB(8, 2, C1, 0);  AT_GAPB(9, 2, C1, 2);   AT_GAPB(10, 2, C1, 4);  AT_GAPB(11, 2, C1, 6);
    AT_GAPB(12, 3, C1, 8); AT_GAPB(13, 3, C1, 10); AT_GAPB(14, 3, C1, 12); AT_GAPB(15, 3, C1, 14);
    at_waitbar<WN>();
    if (resc) {
#pragma unroll
        for (int r = 0; r < 16; ++r) { const float fr_ = X.wsf[crow(r, X.hi)];
#pragma unroll
            for (int i = 0; i < 4; ++i) o[i][r] *= fr_; }
    }
    vs_prev = (vs_prev + 1) & 3; ks_cur = ks_next;
#undef AT_VRD
#undef AT_GAPA
#undef AT_GAPB
#undef AT_PAF
}

__device__ __forceinline__ void attn_mfma(const Frame& F, KArgs a, int l, float lam, const LAS float* biasp) {
    const bf16* Q = (const bf16*)(F.ws + WS_Q); const bf16* Kb = (const bf16*)(F.ws + WS_K); const bf16* VT = (const bf16*)(F.ws + WS_VT); bf16* ABOUT = (bf16*)(F.ws + WS_ABOUT);
    const int lane = F.lane, r32 = lane & 31, hi = lane >> 5, wid = F.wave;
    float* O1S = (float*)(F.ws + WS_O1S) + (size_t)F.blk * 32768 + (size_t)wid * 4096;
    LAS float* wsf = (LAS float*)(F.lds + 2048) + wid * 32;
    LAS unsigned char* tilesK = F.lds + 4096;
    LAS unsigned char* tilesV = F.lds + 4096 + 3 * AT_KT;
    const int vcu = (F.blk & 7) * (F.G >> 3) + (F.blk >> 3);
    const int bh = vcu >> 4, sidx = vcu & 15, b = bh >> 2, h = bh & 3;
    const LAS float* bh_bias = biasp + h * 128;
    constexpr int VTN = AT_VTN;
    LAS float* vt4 = (LAS float*)(F.lds + 98304);
    for (int idx = F.tid; idx < 4 * VTN; idx += NTHR) { const int k = idx / VTN, i = idx % VTN, n = 255 - (i + k); vt4[idx] = (n < 0) ? -INFINITY : (n <= 127 ? bh_bias[n] : 0.f); }
    __syncthreads();
    AtC X;
    X.kvo = (unsigned)(lane * 64 + 8 * wid) * 2u;
    X.vvo0 = (unsigned)(lane * KROWS + 8 * wid) * 2u; X.vvo1 = (unsigned)((64 + lane) * KROWS + 8 * wid) * 2u;
    X.ldsK = (unsigned)(__UINTPTR_TYPE__)tilesK + (unsigned)wid * 1040u; X.ldsV = (unsigned)(__UINTPTR_TYPE__)tilesV + (unsigned)wid * 2064u;
    X.kfo = hi * 1040 + r32 * 16;
    X.vfo = hi * 2064 + r32 * 16;
    X.tilesK = tilesK; X.tilesV = tilesV; X.vt4 = vt4; X.wsf = wsf; X.r32 = r32; X.hi = hi;
#pragma unroll 1
    for (int ui = 0; ui < 2; ++ui) {
        const int qb = (ui == 0) ? 31 - sidx : sidx;
        const int s0w = qb * 256 + wid * 32;
        const int NT = 1 + 4 * (qb + 1);
        X.s0w = s0w;
#pragma unroll 1
        for (int c = 0; c < 2; ++c) {
            X.kgs = Kb + (size_t)(bh * 2 + c) * KROWS * 64;
            X.vgs = VT + (size_t)bh * 128 * KROWS;
#define AT_STAGE_K(t, ks_) glds_r(X.kgs + (size_t)(t) * 4096, X.kvo, (unsigned)__builtin_amdgcn_readfirstlane((int)(X.ldsK + (unsigned)(ks_) * AT_KT)))
#define AT_STAGE_V(t, vs_) do { const unsigned lv_ = (unsigned)__builtin_amdgcn_readfirstlane((int)(X.ldsV + (unsigned)(vs_) * AT_VT)); glds_r(X.vgs + (t) * 64, X.vvo0, lv_); glds_r(X.vgs + (t) * 64, X.vvo1, lv_ + 1024u); } while (0)
            bf16x8 qr[4];
            { int lq = lane; asm volatile("" : "+v"(lq));
              const bf16* qp = Q + ((size_t)(bh * 2 + c) * S + s0w + (lq & 31)) * 64 + (lq >> 5) * 8;
#pragma unroll
              for (int d0 = 0; d0 < 4; ++d0) qr[d0] = *(const bf16x8*)(qp + d0 * 16); }
            f32x16 o[4];
#pragma unroll
            for (int i = 0; i < 4; ++i)
#pragma unroll
                for (int r = 0; r < 16; ++r) o[i][r] = 0.f;
            float mhat = 0.f, lsum = 0.f;
            const f32x16 zero16 = {0.f, 0.f, 0.f, 0.f, 0.f, 0.f, 0.f, 0.f, 0.f, 0.f, 0.f, 0.f, 0.f, 0.f, 0.f, 0.f};
            f32x16 pA0, pA1, pB0, pB1; bf16x8 kf[8];
            __syncthreads();
            AT_STAGE_K(0, 0); AT_STAGE_V(0, 0); AT_STAGE_K(1, 1); AT_STAGE_V(1, 1); AT_STAGE_K(2, 2);
            at_waitbar<4>();
            asm volatile("" : "+v"(qr[0]), "+v"(qr[1]), "+v"(qr[2]), "+v"(qr[3]));
            { const LAS unsigned char* kt = tilesK + X.kfo;
#pragma unroll
              for (int d0 = 0; d0 < 4; ++d0) { kf[2 * d0] = *(const LAS bf16x8*)(kt + d0 * 2080); kf[2 * d0 + 1] = *(const LAS bf16x8*)(kt + d0 * 2080 + 512); } }
            pA0 = AT_MFMA(kf[0], qr[0], zero16); pA1 = AT_MFMA(kf[1], qr[0], zero16); pA0 = AT_MFMA(kf[2], qr[1], pA0); pA1 = AT_MFMA(kf[3], qr[1], pA1);
            pA0 = AT_MFMA(kf[4], qr[2], pA0); pA1 = AT_MFMA(kf[5], qr[2], pA1); pA0 = AT_MFMA(kf[6], qr[3], pA0); pA1 = AT_MFMA(kf[7], qr[3], pA1);
            at_bias<true>(X, -16, pA0, pA1);
            { const float rm = at_rowmax(pA0, pA1); mhat = rm;
#pragma unroll
              for (int r = 0; r < 16; ++r) { pA0[r] = __builtin_amdgcn_exp2f(pA0[r] - rm); pA1[r] = __builtin_amdgcn_exp2f(pA1[r] - rm); } }
            at_waitbar<0>();
            AT_STAGE_K(3, 0); AT_STAGE_V(2, 2);
            { const LAS unsigned char* kt = tilesK + AT_KT + X.kfo;
#pragma unroll
              for (int d0 = 0; d0 < 4; ++d0) { kf[2 * d0] = *(const LAS bf16x8*)(kt + d0 * 2080); kf[2 * d0 + 1] = *(const LAS bf16x8*)(kt + d0 * 2080 + 512); } }
            at_waitbar<3>();
            int ks_cur = 1, vs_prev = 0;
            int t = 1;
#pragma unroll 1
            for (; t + 4 < NT; t += 2) {
                at_step<true, true, true, 3>(X, t, ks_cur, vs_prev, pB0, pB1, pA0, pA1, kf, qr, o, mhat, lsum);
                at_step<true, true, true, 3>(X, t + 1, ks_cur, vs_prev, pA0, pA1, pB0, pB1, kf, qr, o, mhat, lsum);
            }
            at_step<true, true, true, 3>(X, t, ks_cur, vs_prev, pB0, pB1, pA0, pA1, kf, qr, o, mhat, lsum);
            at_step<false, true, true, 2>(X, t + 1, ks_cur, vs_prev, pA0, pA1, pB0, pB1, kf, qr, o, mhat, lsum);
            at_step<false, false, true, 0>(X, t + 2, ks_cur, vs_prev, pB0, pB1, pA0, pA1, kf, qr, o, mhat, lsum);
            at_step<false, false, false, -1>(X, t + 3, ks_cur, vs_prev, pA0, pA1, pB0, pB1, kf, qr, o, mhat, lsum);
            {
                float sacc = 0.f;
#pragma unroll
                for (int r = 0; r < 16; ++r) sacc += pA0[r] + pA1[r];
                lsum += sacc;
                bf16x8 pa[4]; u32x4 w;
                w = (u32x4){cvtpk(pA0[0], pA0[1]), cvtpk(pA0[2], pA0[3]), cvtpk(pA0[4], pA0[5]), cvtpk(pA0[6], pA0[7])}; pa[0] = __builtin_bit_cast(bf16x8, w);
                w = (u32x4){cvtpk(pA0[8], pA0[9]), cvtpk(pA0[10], pA0[11]), cvtpk(pA0[12], pA0[13]), cvtpk(pA0[14], pA0[15])}; pa[1] = __builtin_bit_cast(bf16x8, w);
                w = (u32x4){cvtpk(pA1[0], pA1[1]), cvtpk(pA1[2], pA1[3]), cvtpk(pA1[4], pA1[5]), cvtpk(pA1[6], pA1[7])}; pa[2] = __builtin_bit_cast(bf16x8, w);
                w = (u32x4){cvtpk(pA1[8], pA1[9]), cvtpk(pA1[10], pA1[11]), cvtpk(pA1[12], pA1[13]), cvtpk(pA1[14], pA1[15])}; pa[3] = __builtin_bit_cast(bf16x8, w);
                const LAS unsigned char* vp = tilesV + vs_prev * AT_VT + X.vfo;
#pragma unroll
                for (int ks = 0; ks < 4; ++ks)
#pragma unroll
                    for (int i = 0; i < 4; ++i) { const bf16x8 vf = *(const LAS bf16x8*)(vp + ks * 4128 + i * 512); o[i] = AT_MFMA(pa[ks], vf, o[i]); }
            }
#undef AT_STAGE_K
#undef AT_STAGE_V
            { auto rr = __builtin_amdgcn_permlane32_swap(__builtin_bit_cast(unsigned, lsum), __builtin_bit_cast(unsigned, lsum), false, false); lsum = __builtin_bit_cast(float, rr[0]) + __builtin_bit_cast(float, rr[1]); }
            const int le = lane_id_fresh(), r32e = le & 31, hie = le >> 5;
            if (hie == 0) wsf[r32e] = __builtin_amdgcn_rcpf(lsum);
            LDS_WAIT();
            float* o1p = O1S; bf16* abp = ABOUT; asm volatile("" : "+s"(o1p), "+s"(abp));
            o1p += le * 64;
            float linv[16];
#pragma unroll
            for (int r = 0; r < 16; ++r) linv[r] = wsf[crow(r, hie)];
            if (c == 0) {
#pragma unroll
                for (int i = 0; i < 4; ++i)
#pragma unroll
                    for (int q4 = 0; q4 < 4; ++q4) { const f32x4 v = (f32x4){o[i][4 * q4] * linv[4 * q4], o[i][4 * q4 + 1] * linv[4 * q4 + 1], o[i][4 * q4 + 2] * linv[4 * q4 + 2], o[i][4 * q4 + 3] * linv[4 * q4 + 3]};
                        *(f32x4*)(o1p + (i * 4 + q4) * 4) = v; }
                VM_WAIT();
            } else {
                typedef const __attribute__((address_space(1))) f32x4* gp4_t; typedef const __attribute__((address_space(1))) float* gp1_t;
                const float osc = 1.0f - lambda_init(l); float gn[4];
                { gp1_t sl = (gp1_t)(a->in[I_SUBLN] + l * 128 + r32e);
#pragma unroll
                  for (int i = 0; i < 4; ++i) gn[i] = sl[32 * i]; }
                f32x4 v1[16];
                { gp4_t op = (gp4_t)o1p;
#pragma unroll
                  for (int q = 0; q < 16; ++q) v1[q] = op[q]; }
                __builtin_amdgcn_sched_barrier(0);
#pragma unroll
                for (int i = 0; i < 4; ++i) gn[i] *= osc;
#pragma unroll
                for (int i = 0; i < 4; ++i)
#pragma unroll
                    for (int q4 = 0; q4 < 4; ++q4)
#pragma unroll
                        for (int e = 0; e < 4; ++e) o[i][4 * q4 + e] = v1[i * 4 + q4][e] - lam * (o[i][4 * q4 + e] * linv[4 * q4 + e]);
                const unsigned rowb = (unsigned)(b * S + s0w) * 512u + (unsigned)(h * 128 + r32e);
#pragma unroll
                for (int r = 0; r < 16; ++r) {
                    float ss = (o[0][r] * o[0][r] + o[1][r] * o[1][r]) + (o[2][r] * o[2][r] + o[3][r] * o[3][r]);
                    ss = xor1_add(ss); ss = xor2_add(ss); ss += dpp_f<0x124>(ss); ss += dpp_f<0x128>(ss); ss = xor16_add(ss);
                    const float rs = __builtin_amdgcn_rsqf(ss * (1.0f / 128.0f) + SUBLN_EPS);
                    bf16* dst = abp + (rowb + (unsigned)crow(r, hie) * 512u);
#pragma unroll
                    for (int i = 0; i < 4; ++i) dst[32 * i] = f2bf(o[i][r] * rs * gn[i]);
                }
            }
        }
    }
}

__device__ __forceinline__ void ph_mixers(const Frame& F0, KArgs a, int l) {
    const Frame F = relaunder(F0);
    LAS float* biasp = (LAS float*)(F.lds + 0);
    build_bias(F, a->in[I_RELB], biasp);
    const float lam = layer_lambda(a, l, F.lane);
    __syncthreads();
    if (l == 0 && F.blk == 0) meta_mixers(F, a, l, lam, biasp);
    pool_main(F);
#if USE_MFMA_ATTN
    attn_mfma(F, a, l, lam, biasp);
#else
    attn_simple(F, a, l, lam, biasp);
#endif
}

__device__ __forceinline__ void ph_merge(const Frame& F0, int l) {
    const Frame F = relaunder(F0);
    const bf16* WC = (const bf16*)(F.ws + WS_WC + l * WC_L); const bf16* WAU = (const bf16*)(F.ws + WS_WAU + l * WC_L);
    if (l == 0) {
        EpiPMeta Ep{(const float*)(F.ws + SM_MPROJ), (float*)(F.ws + SM_MTMP)};
        g16_meta<0>(F, (const bf16*)(F.ws + SM_MMIX), 512, WC, 512, 512, D / 32, Ep);
        VM_WAIT();
        EpiQMeta Eq{(const float*)(F.ws + SM_MPROJ), (const float*)(F.ws + SM_MTMP), (bf16*)(F.ws + SM_MMERG)};
        g16_meta<0>(F, (const bf16*)(F.ws + SM_MBOUT), 512, WAU, 512, 512, D / 32, Eq);
    }
    EpiP E1{(const bf16*)(F.ws + WS_G0), (bf16*)(F.ws + WS_TMP)};
    EpiQm E2{(const bf16*)(F.ws + WS_G0), (const bf16*)(F.ws + WS_TMP), (bf16*)(F.ws + WS_MERGED)};
#if USE_PG8
    pg8::StaticOrder So; So.init(M / 256, D / 256, F.G, F.blk);
    pg_gemm<0>(F, (const bf16*)(F.ws + WS_AMIX), WC, 512, So, E1);
    VM_WAIT();
    pg_gemm<0>(F, (const bf16*)(F.ws + WS_ABOUT), WAU, 512, So, E2);
#else
    g16_phase<0>(F, (const bf16*)(F.ws + WS_AMIX), 512, WC, 512, 512, M / 16, D / 32, E1);
    VM_WAIT();
    g16_phase<0>(F, (const bf16*)(F.ws + WS_ABOUT), 512, WAU, 512, 512, M / 16, D / 32, E2);
#endif
}
__device__ __forceinline__ void ph_outproj(const Frame& F0, KArgs a, int l) {
    const Frame F = relaunder(F0);
    const bf16* WOUT = (const bf16*)(F.ws + WS_WOUT + l * WOUT_L);
    if (l == 0) { EpiRes Em{(const float*)(F.ws + SM_MH), (float*)(F.ws + SM_MH)}; g16_meta<0>(F, (const bf16*)(F.ws + SM_MMERG), D, WOUT, D, D, D / 32, Em); }
    pg8::StaticOrder So; So.init(M / 256, D / 256, F.G, F.blk);
    if (l == 0) { EpiResX E{a->in[I_X], (bf16*)(F.ws + WS_H)}; pg_gemm<0>(F, (const bf16*)(F.ws + WS_MERGED), WOUT, D, So, E); }
    else { EpiResH E{(bf16*)(F.ws + WS_H)}; pg_gemm<0>(F, (const bf16*)(F.ws + WS_MERGED), WOUT, D, So, E); }
}
__device__ __forceinline__ void ph_ffn_gu(const Frame& F0) {
    const Frame F = relaunder(F0);
    { EpiGU Em{(bf16*)(F.ws + SM_MACT), 0}; g16_meta<1>(F, (const bf16*)(F.ws + SM_MHN), D, (const bf16*)(F.ws + WS_WGU), D, D, DFF / 32, Em); }
    EpiGU E{(bf16*)(F.ws + WS_ACT), 0};
#if USE_PG8
    pg8::StaticOrder So; So.init(M / 256, DFF / 128, F.G, F.blk); pg_gemm<1>(F, (const bf16*)(F.ws + WS_HN), (const bf16*)(F.ws + WS_WGU), D, So, E);
#else
    g16_phase<1>(F, (const bf16*)(F.ws + WS_HN), D, (const bf16*)(F.ws + WS_WGU), D, D, M / 16, DFF / 32, E);
#endif
}
__device__ __forceinline__ void ph_ffn_down(const Frame& F0) {
    const Frame F = relaunder(F0);
    { EpiRes Em{(const float*)(F.ws + SM_MH), (float*)(F.ws + SM_MH)}; g16_meta<0>(F, (const bf16*)(F.ws + SM_MACT), DFF, (const bf16*)(F.ws + WS_WD), DFF, DFF, D / 32, Em); }
    EpiResH E{(bf16*)(F.ws + WS_H)};
    pg8::StaticOrder So; So.init(M / 256, D / 256, F.G, F.blk); pg_gemm<0>(F, (const bf16*)(F.ws + WS_ACT), (const bf16*)(F.ws + WS_WD), DFF, So, E);
}

__device__ __forceinline__ void ph_route1(const Frame& F0, KArgs a) {
    const Frame F = relaunder(F0);
    LAS float* scr = (LAS float*)(F.lds + F.wave * 16384);
    LAS int* hist = (LAS int*)(F.lds + 12288);
    if (F.tid < 8) hist[F.tid] = 0;
    __syncthreads();
    constexpr int J6 = 16 * 112, J8 = 56 * 32, JE = 2 * J6 + J8;
    const float* gain = a->in[I_NFFN] + D; const float* router = a->in[I_ROUTER];
    float rg[16][8];
#pragma unroll
    for (int j = 0; j < 4; ++j) { const int k0 = rowcol(F.lane, j); const f32x4 g = *(const f32x4*)(gain + k0);
#pragma unroll
        for (int kk = 0; kk < 4; ++kk) { const f32x4 r0 = *(const f32x4*)(router + (size_t)(k0 + kk) * 8), r1 = *(const f32x4*)(router + (size_t)(k0 + kk) * 8 + 4);
#pragma unroll
            for (int e = 0; e < 4; ++e) { rg[4 * j + kk][e] = g[kk] * r0[e]; rg[4 * j + kk][4 + e] = g[kk] * r1[e]; } } }
    const bf16* hrow = (const bf16*)(F.ws + WS_H) + (size_t)(F.blk * 128 + F.wave * 16) * D + 8 * F.lane;
    u32x4 ca = *(const u32x4*)hrow, cb = *(const u32x4*)(hrow + 512);
    auto router_row = [&](int i) { const int row = F.blk * 128 + F.wave * 16 + i;
        const bf16* nrow = hrow + (size_t)((i + 1 < 16) ? i + 1 : i) * D;
        const u32x4 na = *(const u32x4*)nrow, nb = *(const u32x4*)(nrow + 512);
        f32x4 v[4]; unpack8(ca, v[0], v[1]); unpack8(cb, v[2], v[3]);
        const float rs = row_rs(v);
        float lg[8];
#pragma unroll
        for (int e = 0; e < 8; ++e) lg[e] = 0.f;
#pragma unroll
        for (int j = 0; j < 4; ++j)
#pragma unroll
            for (int kk = 0; kk < 4; ++kk)
#pragma unroll
                for (int e = 0; e < 8; ++e) lg[e] += v[j][kk] * rg[4 * j + kk][e];
#pragma unroll
        for (int e = 0; e < 8; ++e) lg[e] = wave_sum(lg[e]) * rs;
        ca = na; cb = nb;
        int e0 = 0; float v0 = lg[0];
#pragma unroll
        for (int e = 1; e < 8; ++e) if (lg[e] > v0) { v0 = lg[e]; e0 = e; }
        int e1 = -1; float v1 = -INFINITY;
#pragma unroll
        for (int e = 0; e < 8; ++e) if (e != e0 && lg[e] > v1) { v1 = lg[e]; e1 = e; }
        const float p1 = __builtin_amdgcn_exp2f((v1 - v0) * LOG2E); const float w0 = 1.0f / (1.0f + p1), w1 = p1 / (1.0f + p1);
        if (F.lane == 0) { ((float*)(F.ws + SM_RS))[row] = rs; ((int*)(F.ws + SM_EW))[row] = e0 | (e1 << 8); ((float*)(F.ws + SM_W0))[row] = w0; ((float*)(F.ws + SM_W1))[row] = w1;
            atomicAdd((int*)&hist[e0], 1); atomicAdd((int*)&hist[e1], 1); }
    };
    int ri = 0;
#pragma unroll 1
    for (int it = F.gw; it < NE * JE; it += F.NGW) { const int e = it / JE; int r = it % JE; TrSrc t; t.col0 = 0;
        if (r < J6) { t.W = a->in[I_MG] + (size_t)e * D * DFF; t.ldw = DFF; t.K = D; t.ncols = DFF; t.WT = F.ws + WS_WGUE + e * WGUE_L; t.row0 = 0; t.gu = 1; }
        else if (r < 2 * J6) { r -= J6; t.W = a->in[I_MU] + (size_t)e * D * DFF; t.ldw = DFF; t.K = D; t.ncols = DFF; t.WT = F.ws + WS_WGUE + e * WGUE_L; t.row0 = 128; t.gu = 1; }
        else { r -= 2 * J6; t.W = a->in[I_MD] + (size_t)e * DFF * D; t.ldw = D; t.K = DFF; t.ncols = D; t.WT = F.ws + WS_WDE + e * WDE_L; t.row0 = 0; t.gu = 0; }
        float wv[32]; tr_load(t, r, F.lane, wv);
        if (ri < 16) { router_row(ri); ++ri; }
        tr_store<true>(t, r, F.lane, wv, scr, SC_W8); }
#pragma unroll 1
    for (; ri < 16; ++ri) router_row(ri);
    __syncthreads();
    if (F.tid < 8) ((int*)(F.ws + SM_HIST))[F.blk * 8 + F.tid] = hist[F.tid];
}
__device__ __forceinline__ void ph_route2(const Frame& F0, KArgs a) {
    const Frame F = relaunder(F0);
    LAS int* tot = (LAS int*)(F.lds + 0);
    LAS int* rslot = (LAS int*)(F.lds + 1024);
    const int* HIST = (const int*)(F.ws + SM_HIST);
    {
        LAS int* wpart = (LAS int*)(F.lds + 2048);
        int c8[8];
#pragma unroll
        for (int e = 0; e < 8; ++e) c8[e] = 0;
        if (F.tid < GRID) { const u32x4 a0 = *(const u32x4*)(HIST + F.tid * 8), a1 = *(const u32x4*)(HIST + F.tid * 8 + 4); c8[0] = a0.x; c8[1] = a0.y; c8[2] = a0.z; c8[3] = a0.w; c8[4] = a1.x; c8[5] = a1.y; c8[6] = a1.z; c8[7] = a1.w; }
        if (F.wave < 4) {
#pragma unroll
            for (int e = 0; e < 8; ++e) { const float tsum = wave_sum((float)c8[e]), bsum = wave_sum((F.tid < F.blk) ? (float)c8[e] : 0.f);
                if (F.lane == 0) { wpart[F.wave * 16 + e] = (int)tsum; wpart[F.wave * 16 + 8 + e] = (int)bsum; } }
        }
        __syncthreads();
        if (F.tid < 16) tot[F.tid] = wpart[F.tid] + wpart[16 + F.tid] + wpart[32 + F.tid] + wpart[48 + F.tid];
    }
    __syncthreads();
    if (F.tid == 0) { int p = 0; for (int e = 0; e < 8; ++e) { tot[32 + e] = p; p += ((tot[e] + 255) >> 8) << 8; } tot[40] = p;
        if (F.blk == 0) { int* PS = (int*)(F.ws + SM_PSTART); for (int e = 0; e <= 8; ++e) PS[e] = tot[32 + e];
            int* PE = (int*)(F.ws + SM_PEXP); for (int e = 0; e < 8; ++e) for (int pp = tot[32 + e] >> 8; pp < (tot[32 + e + 1] >> 8); ++pp) PE[pp] = e; } }
    __syncthreads();
    int e0 = 0, e1 = 0, r0 = 0, r1 = 0;
    if (F.wave < 2) { const int row = F.blk * 128 + F.wave * 64 + F.lane; const int ew = ((const int*)(F.ws + SM_EW))[row]; e0 = ew & 255; e1 = ew >> 8;
#pragma unroll
        for (int e = 0; e < 8; ++e) { const bool f = (e0 == e) || (e1 == e); const unsigned long long mk = __ballot(f); const int rk = __popcll(mk & ((1ull << F.lane) - 1ull));
            if (e0 == e) r0 = rk; if (e1 == e) r1 = rk; if (F.lane == 0) tot[16 + F.wave * 8 + e] = __popcll(mk); } }
    __syncthreads();
    if (F.wave < 2) { const int row = F.blk * 128 + F.wave * 64 + F.lane;
        const int s0 = tot[32 + e0] + tot[8 + e0] + (F.wave == 1 ? tot[16 + e0] : 0) + r0, s1 = tot[32 + e1] + tot[8 + e1] + (F.wave == 1 ? tot[16 + e1] : 0) + r1;
        ((int*)(F.ws + SM_SLOT0))[row] = s0; ((int*)(F.ws + SM_SLOT1))[row] = s1; rslot[(F.wave * 64 + F.lane) * 2] = s0; rslot[(F.wave * 64 + F.lane) * 2 + 1] = s1; }
    __syncthreads();
    const float* gain = a->in[I_NFFN] + D; unsigned char* XG = (unsigned char*)F.out;
    {   f32x4 g[4];
#pragma unroll
        for (int j = 0; j < 4; ++j) g[j] = *(const f32x4*)(gain + rowcol(F.lane, j));
        const bf16* h0 = (const bf16*)(F.ws + WS_H) + (size_t)(F.blk * 128) * D + 8 * F.lane; const float* rsp = (const float*)(F.ws + SM_RS) + F.blk * 128;
        u32x4 ca = *(const u32x4*)(h0 + (size_t)F.wave * D), cb = *(const u32x4*)(h0 + (size_t)F.wave * D + 512); float crs = rsp[F.wave];
#pragma unroll 1
        for (int i = F.wave; i < 128; i += NWAVES) { const int ni = (i + NWAVES < 128) ? i + NWAVES : i;
            const u32x4 na = *(const u32x4*)(h0 + (size_t)ni * D), nb = *(const u32x4*)(h0 + (size_t)ni * D + 512); const float nrs = rsp[ni];
            const float rs = crs * SC_X8; f32x4 v[4]; unpack8(ca, v[0], v[1]); unpack8(cb, v[2], v[3]); const int s0 = rslot[i * 2], s1 = rslot[i * 2 + 1];
            u32x2 wa, wb;
            { const f32x4 o0 = v[0] * rs * g[0], o1 = v[1] * rs * g[1]; wa.x = pk4_fp8(o0[0], o0[1], o0[2], o0[3]); wa.y = pk4_fp8(o1[0], o1[1], o1[2], o1[3]); }
            { const f32x4 o2 = v[2] * rs * g[2], o3 = v[3] * rs * g[3]; wb.x = pk4_fp8(o2[0], o2[1], o2[2], o2[3]); wb.y = pk4_fp8(o3[0], o3[1], o3[2], o3[3]); }
            *(u32x2*)(XG + (size_t)s0 * D + 8 * F.lane) = wa; *(u32x2*)(XG + (size_t)s0 * D + 512 + 8 * F.lane) = wb;
            *(u32x2*)(XG + (size_t)s1 * D + 8 * F.lane) = wa; *(u32x2*)(XG + (size_t)s1 * D + 512 + 8 * F.lane) = wb;
            ca = na; cb = nb; crs = nrs; }
    }
}
struct EpiGU8 {
    unsigned char* ACT;
    __device__ __forceinline__ void put8x2(int row, int col, f32x4 g0, f32x4 g1, f32x4 u0, f32x4 u1) const {
        constexpr float si = 1.0f / (SC_X8 * SC_W8), ce = -si * LOG2E, kc = 1.0f / (si * si * SC_A8);
        f32x4 x0, x1;
#pragma unroll
        for (int e = 0; e < 4; ++e) { x0[e] = (g0[e] * u0[e]) * __builtin_amdgcn_rcpf(__builtin_fmaf(__builtin_amdgcn_exp2f(g0[e] * ce), kc, kc));
                                      x1[e] = (g1[e] * u1[e]) * __builtin_amdgcn_rcpf(__builtin_fmaf(__builtin_amdgcn_exp2f(g1[e] * ce), kc, kc)); }
        u32x2 w; w.x = pk4_fp8(x0[0], x0[1], x0[2], x0[3]); w.y = pk4_fp8(x1[0], x1[1], x1[2], x1[3]);
        *(u32x2*)(ACT + (size_t)row * DFF + col) = w;
    }
};
struct EpiY8 {
    bf16* Y;
    __device__ __forceinline__ void put8(int row, int col, f32x4 lo, f32x4 hi) const { constexpr float si = 1.0f / (SC_A8 * SC_W8); *(u32x4*)(Y + (size_t)row * D + col) = pack8(lo * si, hi * si); }
};
__device__ __forceinline__ void ph_moe_gu(const Frame& F0) {
    const Frame F = relaunder(F0);
    const int P = __builtin_amdgcn_readfirstlane(((const int*)(F.ws + SM_PSTART))[8] >> 8); const int* PE = (const int*)(F.ws + SM_PEXP);
    EpiGU8 E{F.ws + WS_ACTE};
    MoeOrder So; So.so.init(P, DFF / 128, F.G, F.blk); So.p0 = 0; So.PE = PE; So.nbt = DFF / 128; So.a_abs = 1;
    pg_gemm<1, EpiGU8, MoeOrder, true>(F, (const bf16*)F.out, (const bf16*)(F.ws + WS_WGUE), D, So, E);
}
__device__ __forceinline__ void ph_moe_down(const Frame& F0) {
    const Frame F = relaunder(F0);
    const int P = __builtin_amdgcn_readfirstlane(((const int*)(F.ws + SM_PSTART))[8] >> 8); const int* PE = (const int*)(F.ws + SM_PEXP);
    EpiY8 E{(bf16*)(F.ws + WS_Y)};
    MoeOrder So; So.so.init(P, D / 256, F.G, F.blk); So.p0 = 0; So.PE = PE; So.nbt = D / 256; So.a_abs = 1; So.imax = MOE_DOWN_FULL;
    pg_gemm<0, EpiY8, MoeOrder, true>(F, (const bf16*)(F.ws + WS_ACTE), (const bf16*)(F.ws + WS_WDE), DFF, So, E);
}
__device__ __forceinline__ bool cmb_bad(const LAS unsigned* pmask, int s) { const int pnl = s >> 8; return (pmask[pnl >> 5] >> (pnl & 31)) & 1u; }
__device__ __forceinline__ void ph_tail_combine(const Frame& F0, KArgs a) {
    const Frame F = relaunder(F0);
    const int P = __builtin_amdgcn_readfirstlane(((const int*)(F.ws + SM_PSTART))[8] >> 8); const int* PE = (const int*)(F.ws + SM_PEXP);
    int nx = 4 * P - MOE_DOWN_FULL * F.G; nx = nx < 0 ? 0 : nx;
    LAS unsigned* pmask = (LAS unsigned*)(F.lds + RING_BYTES + 4096);
    if (F.tid < 16) pmask[F.tid] = 0u;
    __syncthreads();
    { pg8::StaticOrder so; so.init(P, D / 256, F.G, 0); pg8::Unit u; if (F.tid < nx && so.unit_of((long)MOE_DOWN_FULL * F.G + F.tid, u)) atomicOr((unsigned*)&pmask[u.pm >> 5], 1u << (u.pm & 31)); }
    __syncthreads();
    if (F.blk < nx) {
        EpiY8 E{(bf16*)(F.ws + WS_Y)};
        MoeOrder So; So.so.init(P, D / 256, F.G, F.blk); So.p0 = 0; So.PE = PE; So.nbt = D / 256; So.a_abs = 1; So.imin = MOE_DOWN_FULL;
        pg_gemm<0, EpiY8, MoeOrder, true>(F, (const bf16*)(F.ws + WS_ACTE), (const bf16*)(F.ws + WS_WDE), DFF, So, E);
        return;
    }
    const int gw = (F.blk - nx) * NWAVES + F.wave, NGW = (F.G - nx) * NWAVES;
    const bf16* Y = (const bf16*)(F.ws + WS_Y); const bf16* H = (const bf16*)(F.ws + WS_H); const float* gain = a->in[I_FNORM];
    {
        f32x4 g[4];
#pragma unroll
        for (int j = 0; j < 4; ++j) g[j] = *(const f32x4*)(gain + rowcol(F.lane, j));
        const int* SL0 = (const int*)(F.ws + SM_SLOT0); const int* SL1 = (const int*)(F.ws + SM_SLOT1); const float* W0 = (const float*)(F.ws + SM_W0); const float* W1 = (const float*)(F.ws + SM_W1);
        const int lo8 = 8 * F.lane;
        const int r0 = gw; const int r1 = (r0 + NGW < M) ? r0 + NGW : r0;
        int cs0 = SL0[r0], cs1 = SL1[r0]; float cw0 = W0[r0], cw1 = W1[r0];
        int ns0 = SL0[r1], ns1 = SL1[r1]; float nw0 = W0[r1], nw1 = W1[r1];
        u32x4 ch[2], cy[2], cz[2];
        ch[0] = *(const u32x4*)(H + (size_t)r0 * D + lo8); ch[1] = *(const u32x4*)(H + (size_t)r0 * D + 512 + lo8);
        cy[0] = *(const u32x4*)(Y + (size_t)cs0 * D + lo8); cy[1] = *(const u32x4*)(Y + (size_t)cs0 * D + 512 + lo8);
        cz[0] = *(const u32x4*)(Y + (size_t)cs1 * D + lo8); cz[1] = *(const u32x4*)(Y + (size_t)cs1 * D + 512 + lo8);
#pragma unroll 1
        for (int row = r0; row < M; row += NGW) {
            const int rn = (row + NGW < M) ? row + NGW : row, rnn = (rn + NGW < M) ? rn + NGW : rn;
            u32x4 nh[2], ny[2], nz[2];
            nh[0] = *(const u32x4*)(H + (size_t)rn * D + lo8); nh[1] = *(const u32x4*)(H + (size_t)rn * D + 512 + lo8);
            ny[0] = *(const u32x4*)(Y + (size_t)ns0 * D + lo8); ny[1] = *(const u32x4*)(Y + (size_t)ns0 * D + 512 + lo8);
            nz[0] = *(const u32x4*)(Y + (size_t)ns1 * D + lo8); nz[1] = *(const u32x4*)(Y + (size_t)ns1 * D + 512 + lo8);
            const int fs0 = SL0[rnn], fs1 = SL1[rnn]; const float fw0 = W0[rnn], fw1 = W1[rnn];
            if (!(cmb_bad(pmask, cs0) || cmb_bad(pmask, cs1))) {
                f32x4 v[4], ya[4], yb[4]; unpack8(ch[0], v[0], v[1]); unpack8(ch[1], v[2], v[3]); unpack8(cy[0], ya[0], ya[1]); unpack8(cy[1], ya[2], ya[3]); unpack8(cz[0], yb[0], yb[1]); unpack8(cz[1], yb[2], yb[3]);
#pragma unroll
                for (int j = 0; j < 4; ++j) v[j] = v[j] + ya[j] * cw0 + yb[j] * cw1;
                const float rs = row_rs(v);
                float* orow = F.out + (size_t)row * D;
#pragma unroll
                for (int j = 0; j < 4; ++j) *(f32x4*)(orow + rowcol(F.lane, j)) = v[j] * rs * g[j];
            }
            ch[0] = nh[0]; ch[1] = nh[1]; cy[0] = ny[0]; cy[1] = ny[1]; cz[0] = nz[0]; cz[1] = nz[1];
            cs0 = ns0; cs1 = ns1; cw0 = nw0; cw1 = nw1; ns0 = fs0; ns1 = fs1; nw0 = fw0; nw1 = fw1;
        }
    }
}
__device__ __forceinline__ void ph_combine2(const Frame& F0, KArgs a) {
    const Frame F = relaunder(F0);
    const LAS unsigned* pmask = (const LAS unsigned*)(F.lds + RING_BYTES + 4096);
    const bf16* Y = (const bf16*)(F.ws + WS_Y); const bf16* H = (const bf16*)(F.ws + WS_H); const float* gain = a->in[I_FNORM];
    const int* SL0 = (const int*)(F.ws + SM_SLOT0); const int* SL1 = (const int*)(F.ws + SM_SLOT1);
#pragma unroll 1
    for (int row = F.gw; row < M; row += F.NGW) {
        const int s0 = __builtin_amdgcn_readfirstlane(SL0[row]), s1 = __builtin_amdgcn_readfirstlane(SL1[row]);
        if (!(cmb_bad(pmask, s0) || cmb_bad(pmask, s1))) continue;
        const float w0 = ((const float*)(F.ws + SM_W0))[row], w1 = ((const float*)(F.ws + SM_W1))[row];
        f32x4 v[4], ya[4], yb[4]; load_row_b(H + (size_t)row * D, F.lane, v); load_row_b(Y + (size_t)s0 * D, F.lane, ya); load_row_b(Y + (size_t)s1 * D, F.lane, yb);
#pragma unroll
        for (int j = 0; j < 4; ++j) v[j] = v[j] + ya[j] * w0 + yb[j] * w1;
        const float rs = row_rs(v);
        float* orow = F.out + (size_t)row * D;
#pragma unroll
        for (int j = 0; j < 4; ++j) { const int c0 = rowcol(F.lane, j); *(f32x4*)(orow + c0) = v[j] * rs * *(const f32x4*)(gain + c0); }
    }
}

__device__ __forceinline__ bool opaque_true() { int one = 1; asm volatile("" : "+s"(one)); return one != 0; }
enum { PH_P0 = 0, PH_G1_0, PH_A_0, PH_G2_0, PH_G3_0, PH_N2_0, PH_F1_0, PH_F2_0, PH_N1_1, PH_G1_1, PH_A_1, PH_G2_1, PH_G3_1, PH_R1, PH_R2, PH_F1A, PH_F2A, PH_C, PH_C2, NPH };
__global__ void __launch_bounds__(NTHR, 2) fwd(Args args) {
    extern __shared__ __attribute__((aligned(16))) unsigned char lds_raw[];
    Frame F;
    F.lds = (LAS unsigned char*)lds_raw; F.ws = args.ws; F.out = args.out;
    F.tid = threadIdx.x; F.lane = F.tid & 63; F.wave = __builtin_amdgcn_readfirstlane(F.tid >> 6);
    F.G = gridDim.x; F.blk = blockIdx.x; F.gw = F.blk * NWAVES + F.wave; F.NGW = F.G * NWAVES;
    volatile LAS unsigned* MISC = (volatile LAS unsigned*)(F.lds + MISC_OFF);
    for (int u = F.tid; u < (LDS_BYTES - LDSCTL_OFF) / 4; u += NTHR) ((LAS unsigned*)(F.lds + LDSCTL_OFF))[u] = 0u;
    __syncthreads();
    XcdBarrier bar; bar.bar = (unsigned*)(F.ws + WS_CTL) + CW_BAR; bar.x = 0; bar.st = nullptr;
    if (NLAUNCH == 1) bar = xcd_barrier_post((unsigned*)(F.ws + WS_CTL) + CW_BAR, MISC + 8, F.tid);
    const int lo = args.ph_lo, hi = args.ph_hi;
#define IN(k) (NLAUNCH == 1 ? opaque_true() : (lo <= (k) && (k) < hi))
#define SEAM(k) do { if (NLAUNCH == 1) { XcdBarrier b2_ = bar; asm volatile("" : "+s"(b2_.bar)); xcd_barrier(b2_, F.wave); } } while (0)

    if (IN(PH_P0)) { ph_prologue(F, kargs()); } SEAM(PH_P0);
#pragma unroll 1
    for (int l = 0; l < 2; ++l) {
        const int pb = (l == 0) ? PH_G1_0 : PH_G1_1;
        if (l == 1) { if (IN(PH_N1_1)) { ph_norm(F, 1); } SEAM(PH_N1_1); }
        if (IN(pb)) { ph_inproj(F, l); } SEAM(pb);
        if (IN(pb + 1)) { ph_mixers(F, kargs(), l); } SEAM(pb + 1);
#if PROBE_DUP == 1
        if (IN(pb + 1)) { ph_mixers(F, kargs(), l); } SEAM(pb + 1);
#endif
        if (IN(pb + 2)) { ph_merge(F, l); } SEAM(pb + 2);
        if (IN(pb + 3)) { ph_outproj(F, kargs(), l); } SEAM(pb + 3);
        if (l == 0) {
            if (IN(PH_N2_0)) { ph_norm(F, 0); } SEAM(PH_N2_0);
            if (IN(PH_F1_0)) { ph_ffn_gu(F); } SEAM(PH_F1_0);
            if (IN(PH_F2_0)) { ph_ffn_down(F); } SEAM(PH_F2_0);
        }
    }
    if (IN(PH_R1)) { ph_route1(F, kargs()); } SEAM(PH_R1);
    if (IN(PH_R2)) { ph_route2(F, kargs()); } SEAM(PH_R2);
    if (IN(PH_F1A)) { ph_moe_gu(F); } SEAM(PH_F1A);
    if (IN(PH_F2A)) { ph_moe_down(F); } SEAM(PH_F2A);
    if (IN(PH_C)) { ph_tail_combine(F, kargs()); } SEAM(PH_C);
    if (IN(PH_C2)) { ph_combine2(F, kargs()); }
#undef IN
#undef SEAM
}

extern "C" void kernel_launch(void* const* d_in, const int* in_sizes, int n_in, void* d_out, int out_size, void* d_ws, size_t ws_size, hipStream_t stream) {
    static int ready = 0;
    if (ready == 0) {
        if (n_in != 24 || in_sizes[0] != M * D || out_size != M * D || ws_size < WS_END) { fprintf(stderr, "kernel_launch: shape/workspace mismatch (n_in %d, in0 %d, out %d, ws %zu, need %zu)\n", n_in, n_in > 0 ? in_sizes[0] : -1, out_size, ws_size, (size_t)WS_END); ready = -1; return; }
        if (hipFuncSetAttribute((const void*)fwd, hipFuncAttributeMaxDynamicSharedMemorySize, LDS_BYTES) != hipSuccess) { fprintf(stderr, "kernel_launch: hipFuncSetAttribute failed\n"); ready = -1; return; }
        int per_cu = 0;
        if (hipOccupancyMaxActiveBlocksPerMultiprocessor(&per_cu, (const void*)fwd, NTHR, LDS_BYTES) != hipSuccess || per_cu < 1) fprintf(stderr, "kernel_launch: occupancy query reports %d\n", per_cu);
        (void)hipGetLastError();
        ready = 1;
    }
    if (ready < 0) return;
    (void)hipMemsetAsync((char*)d_ws + WS_CTL, 0, CTL_ZERO_BYTES, stream);
    Args a{};
    for (int i = 0; i < 24; ++i) a.in[i] = (const float*)d_in[i];
    a.out = (float*)d_out; a.ws = (unsigned char*)d_ws;
    for (int li = 0; li < NLAUNCH; ++li) {
        a.ph_lo = (NLAUNCH == 1) ? 0 : li; a.ph_hi = (NLAUNCH == 1) ? NPH : li + 1;
        hipLaunchKernelGGL(fwd, dim3(GRID), dim3(NTHR), LDS_BYTES, stream, a);
    }
}
```

```cpp
#include <hip/hip_runtime.h>
#include <cstdio>
#include <cstdint>

#ifndef PROBE_DUP
#define PROBE_DUP 0
#endif
#ifndef USE_MFMA_ATTN
#define USE_MFMA_ATTN 1
#endif
#ifndef USE_PG8
#define USE_PG8 1
#endif
#ifndef NLAUNCH
#define NLAUNCH 1
#endif

#define GAS __attribute__((address_space(1)))
#define LAS __attribute__((address_space(3)))
typedef unsigned short bf16;
typedef short bf16x8 __attribute__((ext_vector_type(8)));
typedef float f32x4 __attribute__((ext_vector_type(4)));
typedef float f32x2 __attribute__((ext_vector_type(2)));
typedef unsigned u32x4 __attribute__((ext_vector_type(4)));
typedef unsigned u32x2 __attribute__((ext_vector_type(2)));
typedef __bf16 bf16x2_t __attribute__((ext_vector_type(2)));

constexpr int D = 1024, NB = 4, S = 8192, NMETA = 16, M = NB * S;
constexpr int NH = 4, DK = 64, DV = 128;
constexpr int NIN = 3584;
constexpr int DFF = 3584, NE = 8;
constexpr int KROWS = 64 + S;
constexpr float RMS_EPS = 1e-6f, SUBLN_EPS = 1e-5f;
constexpr float LOG2E = 1.4426950408889634f;
constexpr float C2 = 0.125f * LOG2E;
constexpr int NWAVES = 8, NTHR = 512, GRID = 256;
constexpr int MAXPANELS = 264;

constexpr size_t MiB = 1u << 20;
constexpr size_t WS_CTL = 0, CTL_ZERO_BYTES = 1 * MiB;
constexpr size_t WS_SMALL = 1 * MiB;
constexpr size_t SM_MH = WS_SMALL + 0, SM_MHN = WS_SMALL + 64 * 1024, SM_MPROJ = WS_SMALL + 96 * 1024, SM_MMIX = WS_SMALL + 352 * 1024, SM_MBOUT = WS_SMALL + 368 * 1024,
                 SM_MTMP = WS_SMALL + 384 * 1024, SM_MMERG = WS_SMALL + 448 * 1024, SM_MACT = WS_SMALL + 480 * 1024;
constexpr size_t SM_RS = WS_SMALL + 1 * MiB, SM_EW = SM_RS + 128 * 1024, SM_W0 = SM_EW + 128 * 1024, SM_W1 = SM_W0 + 128 * 1024, SM_SLOT0 = SM_W1 + 128 * 1024, SM_SLOT1 = SM_SLOT0 + 128 * 1024;
constexpr size_t SM_HIST = WS_SMALL + 2 * MiB, SM_PSTART = SM_HIST + 8192, SM_PEXP = SM_PSTART + 1024;
constexpr size_t WS_WIN = 8 * MiB;
constexpr size_t WIN_L = (size_t)NIN * D * 2;
constexpr size_t WS_WV = WS_WIN + 2 * WIN_L;
constexpr size_t WV_L = (size_t)512 * D * 2;
constexpr size_t WS_WC = WS_WV + 2 * WV_L;
constexpr size_t WC_L = (size_t)D * 512 * 2;
constexpr size_t WS_WAU = WS_WC + 2 * WC_L;
constexpr size_t WS_WOUT = WS_WAU + 2 * WC_L;
constexpr size_t WOUT_L = (size_t)D * D * 2;
constexpr size_t WS_WGU = WS_WOUT + 2 * WOUT_L;
constexpr size_t WS_WD = WS_WGU + (size_t)2 * DFF * D * 2;
constexpr size_t WS_WN_END = WS_WD + (size_t)D * DFF * 2;
static_assert(WS_WN_END <= 54 * MiB, "non-MoE weights");
constexpr size_t WS_HN = 54 * MiB;
constexpr size_t WS_AMIX = WS_HN, WS_ABOUT = WS_HN + 32 * MiB;
constexpr size_t WS_U = 118 * MiB;
constexpr int UROWS = NMETA + S;
constexpr size_t WS_VT = 150 * MiB + 128 * 1024;
constexpr size_t WS_Q = 183 * MiB;
constexpr size_t WS_K = 215 * MiB;
constexpr size_t WS_G0 = 248 * MiB, WS_G1 = 312 * MiB;
constexpr size_t WS_O1S = 376 * MiB;
constexpr size_t WS_TMP = 183 * MiB;
constexpr size_t WS_MERGED = 118 * MiB;
constexpr size_t WS_ACT = 118 * MiB;
static_assert(WS_VT + (size_t)NB * NH * 128 * KROWS * 2 <= 183 * MiB && (size_t)NB * NH * 2 * KROWS * 64 * 2 <= 33 * MiB && WS_U + (size_t)NB * UROWS * 512 * 2 <= WS_VT, "U/K/VT regions");
constexpr size_t WS_WGUE = 8 * MiB;
constexpr size_t WGUE_L = (size_t)2 * DFF * D;
constexpr size_t WS_WDE = 64 * MiB;
constexpr size_t WDE_L = (size_t)D * DFF;
constexpr size_t WS_Y = 92 * MiB;
constexpr size_t WS_ACTE = 224 * MiB;
constexpr size_t WS_H = 482 * MiB;
constexpr size_t WS_END = 546 * MiB;
static_assert(WS_WGUE + 8 * WGUE_L <= WS_WDE && WS_WDE + 8 * WDE_L <= WS_Y && WS_Y + (size_t)MAXPANELS * 256 * D * 2 <= WS_ACTE && WS_ACTE + (size_t)MAXPANELS * 256 * DFF <= WS_H && WS_H + (size_t)M * D * 2 <= WS_END && (size_t)MAXPANELS * 256 * D <= (size_t)M * D * 4 && WS_O1S + 32 * MiB <= WS_H, "MoE map");
constexpr float SC_W8 = 512.f, SC_X8 = 16.f, SC_A8 = 8.f;

constexpr int CW_BAR = 4096;

constexpr int RING_BYTES = 131072;
constexpr int LDSCTL_OFF = RING_BYTES, MISC_OFF = LDSCTL_OFF + 320;
constexpr int LDS_BYTES = 147456;

#define RLX_AGENT __ATOMIC_RELAXED, __HIP_MEMORY_SCOPE_AGENT
__device__ __forceinline__ int lane_id_fresh() { int l; asm volatile("v_mbcnt_lo_u32_b32 %0, -1, 0\n\tv_mbcnt_hi_u32_b32 %0, -1, %0" : "=v"(l)); return l; }
#define LDS_WAIT() asm volatile("s_waitcnt lgkmcnt(0)" ::: "memory")
#define VM_WAIT() asm volatile("s_waitcnt vmcnt(0)" ::: "memory")
__device__ __forceinline__ unsigned cvtpk(float lo, float hi) { f32x2 v = {lo, hi}; bf16x2_t b = __builtin_convertvector(v, bf16x2_t); return __builtin_bit_cast(unsigned, b); }
__device__ __forceinline__ u32x4 pack8(f32x4 a, f32x4 b) { u32x4 w; w.x = cvtpk(a[0], a[1]); w.y = cvtpk(a[2], a[3]); w.z = cvtpk(b[0], b[1]); w.w = cvtpk(b[2], b[3]); return w; }
__device__ __forceinline__ float bflo(unsigned w) { return __builtin_bit_cast(float, w << 16); }
__device__ __forceinline__ float bfhi(unsigned w) { return __builtin_bit_cast(float, w & 0xffff0000u); }
__device__ __forceinline__ void unpack8(u32x4 w, f32x4& a, f32x4& b) { a = (f32x4){bflo(w.x), bfhi(w.x), bflo(w.y), bfhi(w.y)}; b = (f32x4){bflo(w.z), bfhi(w.z), bflo(w.w), bfhi(w.w)}; }
__device__ __forceinline__ unsigned pk4_fp8(float a, float b, float c, float d) { int p = __builtin_amdgcn_cvt_pk_fp8_f32(a, b, 0, false); p = __builtin_amdgcn_cvt_pk_fp8_f32(c, d, p, true); return (unsigned)p; }
__device__ __forceinline__ float bf2f(bf16 b) { return __builtin_bit_cast(float, (unsigned)b << 16); }
__device__ __forceinline__ bf16 f2bf(float f) { return (bf16)(cvtpk(f, 0.f) & 0xffffu); }
template <int CTRL> __device__ __forceinline__ float dpp_f(float v) { return __builtin_bit_cast(float, __builtin_amdgcn_update_dpp(0, __builtin_bit_cast(int, v), CTRL, 0xf, 0xf, true)); }
__device__ __forceinline__ float xor1_add(float v) { return v + dpp_f<0xB1>(v); }
__device__ __forceinline__ float xor2_add(float v) { return v + dpp_f<0x4E>(v); }
__device__ __forceinline__ float swap16_add(float v) { auto r = __builtin_amdgcn_permlane16_swap(__builtin_bit_cast(unsigned, v), __builtin_bit_cast(unsigned, v), false, false); return __builtin_bit_cast(float, r[0]) + __builtin_bit_cast(float, r[1]); }
__device__ __forceinline__ float swap32_add(float v) { auto r = __builtin_amdgcn_permlane32_swap(__builtin_bit_cast(unsigned, v), __builtin_bit_cast(unsigned, v), false, false); return __builtin_bit_cast(float, r[0]) + __builtin_bit_cast(float, r[1]); }
__device__ __forceinline__ float wave_sum(float v) {
    v = xor1_add(v); v = xor2_add(v); v += dpp_f<0x124>(v); v += dpp_f<0x128>(v);
    const int vi = __builtin_bit_cast(int, v);
    const float r0 = __builtin_bit_cast(float, __builtin_amdgcn_readlane(vi, 0)), r1 = __builtin_bit_cast(float, __builtin_amdgcn_readlane(vi, 16)), r2 = __builtin_bit_cast(float, __builtin_amdgcn_readlane(vi, 32)), r3 = __builtin_bit_cast(float, __builtin_amdgcn_readlane(vi, 48));
    return (r0 + r1) + (r2 + r3);
}
__device__ __forceinline__ float sigmoidf_(float x) { return __builtin_amdgcn_rcpf(1.0f + __builtin_amdgcn_exp2f(x * -LOG2E)); }
__device__ __forceinline__ f32x4 sig4(f32x4 v) { return (f32x4){sigmoidf_(v[0]), sigmoidf_(v[1]), sigmoidf_(v[2]), sigmoidf_(v[3])}; }
__device__ __forceinline__ int vperm16(int t) { const int g4 = (t >> 2) & 3; const int sg = (g4 == 1) ? 2 : (g4 == 2) ? 1 : g4; return (t & ~15) + 4 * sg + (t & 3); }

__device__ __forceinline__ int t5_bucket(int n) {
    if (n < 16) return n;
    const int th[16] = {16, 19, 21, 24, 27, 31, 35, 40, 46, 52, 59, 67, 77, 87, 99, 113};
    int b = 16;
#pragma unroll
    for (int j = 1; j < 16; ++j) b += (n >= th[j]) ? 1 : 0;
    return b;
}

#define XB_TMO      128
#define XB_XCNT(j)  (256  + 64 * (j))
#define XB_XSUB(j)  (1280 + 64 * (j))
#define XB_XGEN(j)  (2304 + 64 * (j))
#define XB_TOP      3328
#define XB_TOPGEN   3392
#define XCD_BAR_WORDS 3456
#define XB_SPIN_CAP (1u << 22)
__device__ __forceinline__ unsigned xb_ld(unsigned* p)              { return __hip_atomic_load(p, __ATOMIC_RELAXED, __HIP_MEMORY_SCOPE_AGENT); }
__device__ __forceinline__ unsigned xb_add(unsigned* p, unsigned v) { return __hip_atomic_fetch_add(p, v, __ATOMIC_RELAXED, __HIP_MEMORY_SCOPE_AGENT); }
__device__ __forceinline__ unsigned xb_xcc_id() { return (unsigned)__builtin_amdgcn_s_getreg((3 << 11) | 20) & 0xFu; }
#define XB_SPIN(cond, bar) do { unsigned _sp = 0; while (cond) { __builtin_amdgcn_s_sleep(1); \
    if ((++_sp & 255u) == 0u) { if (xb_ld(&(bar)[XB_TMO])) break; if (_sp > XB_SPIN_CAP) { atomicAdd(&(bar)[XB_TMO], 1u); break; } } } } while (0)
struct XcdBarrier { unsigned* bar; unsigned x; volatile LAS unsigned* st; };
__device__ __forceinline__ XcdBarrier xcd_barrier_post(unsigned* bar, volatile LAS unsigned* st, int tid) {
    XcdBarrier b; b.bar = bar; b.x = xb_xcc_id(); b.st = st;
    if (tid == 0) (void)xb_add(&bar[XB_XCNT(b.x)], 1u);
    return b;
}
__device__ __forceinline__ void xcd_barrier_complete(unsigned* bar, unsigned x, unsigned& nloc, unsigned& nx) {
    const unsigned G = gridDim.x * gridDim.y * gridDim.z;
    unsigned sum, cnt, mine, sp = 0u;
    for (;;) {
        sum = 0u; cnt = 0u; mine = 0u;
#pragma unroll
        for (unsigned j = 0; j < 16; ++j) { const unsigned c = xb_ld(&bar[XB_XCNT(j)]); sum += c; cnt += (c > 0u) ? 1u : 0u; mine = (j == x) ? c : mine; }
        if (sum == G) break;
        __builtin_amdgcn_s_sleep(1);
        if ((++sp & 255u) == 0u) { if (xb_ld(&bar[XB_TMO])) break; if (sp > XB_SPIN_CAP) { atomicAdd(&bar[XB_TMO], 1u); break; } }
    }
    nloc = mine > 0u ? mine : 1u; nx = cnt > 0u ? cnt : 1u;
}
__device__ __forceinline__ void xcd_barrier(const XcdBarrier& b, int wave_s) {
    asm volatile("s_waitcnt vmcnt(0)" ::: "memory");
    __syncthreads();
    if (wave_s == 0 && lane_id_fresh() == 0) {
        unsigned* bar = b.bar;
        __builtin_amdgcn_s_waitcnt(0);
        unsigned nloc = b.st[0], nx = b.st[1];
        if (nloc == 0u) { xcd_barrier_complete(bar, b.x, nloc, nx); b.st[0] = nloc; b.st[1] = nx; }
        const unsigned old = xb_add(&bar[XB_XSUB(b.x)], 1u);
        const unsigned gen = old / nloc;
        if (old + 1u == (gen + 1u) * nloc) {
            __builtin_amdgcn_fence(__ATOMIC_RELEASE, "agent");
            asm volatile("s_waitcnt vmcnt(0)" ::: "memory");
            const unsigned og = xb_add(&bar[XB_TOP], 1u);
            const unsigned tg = og / nx;
            if (og + 1u == (tg + 1u) * nx) xb_add(&bar[XB_TOPGEN], 1u);
            else XB_SPIN(xb_ld(&bar[XB_TOPGEN]) == tg, bar);
            __builtin_amdgcn_fence(__ATOMIC_ACQUIRE, "agent");
            xb_add(&bar[XB_XGEN(b.x)], 1u);
            asm volatile("s_waitcnt vmcnt(0)" ::: "memory");
        } else {
            XB_SPIN(xb_ld(&bar[XB_XGEN(b.x)]) == gen, bar);
            __builtin_amdgcn_fence(__ATOMIC_ACQUIRE, "agent");
            asm volatile("s_waitcnt vmcnt(0)" ::: "memory");
        }
    }
    __syncthreads();
}

namespace pg8 {
#define PG8_LAS __attribute__((address_space(3)))
typedef unsigned short bf16_t;
constexpr int BM = 256, BK = 64, HALF = 128, HTB = HALF * BK * 2, STAGE_BYTES = 8 * HTB, NXCD = 8, WGM = 8;
__host__ __device__ __forceinline__ int lds_byte(int r, int c) { const int st = (r >> 4) * 2 + (c >> 5), rr = r & 15, cc = c & 31, ob = rr * 64 + cc * 2; return st * 1024 + (ob ^ (((ob >> 9) & 1) << 5)); }
__host__ __device__ __forceinline__ void stage_rc(int b, int& R, int& C) { const int st = b / 1024, sb = b % 1024, swz = sb ^ (((sb >> 9) & 1) << 5); R = (st >> 1) * 16 + swz / 64; C = (st & 1) * 32 + (swz % 64) / 2; }
__host__ __device__ __forceinline__ int perm32(int rho) { const int n = rho >> 4, i = rho & 15; return 8 * (i >> 2) + 4 * n + (i & 3); }
typedef int i32x4_t __attribute__((ext_vector_type(4))); typedef int i32x8_t __attribute__((ext_vector_type(8)));
__device__ __forceinline__ i32x8_t ld32(const PG8_LAS unsigned char* p) { const i32x4_t lo = *(const PG8_LAS i32x4_t*)p, hi = *(const PG8_LAS i32x4_t*)(p + 1024); return __builtin_shufflevector(lo, hi, 0, 1, 2, 3, 4, 5, 6, 7); }
template <int OFF> __device__ __forceinline__ void glds_s(const void* sbase, unsigned voff, unsigned ldsbase) {
    asm volatile("s_add_i32 m0, %2, %3\n\ts_nop 0\n\tglobal_load_lds_dwordx4 %0, %1" :: "v"(voff), "s"(sbase), "s"(ldsbase), "i"(OFF) : "memory", "m0", "scc"); }
struct Unit { int pm, pn, pb, po; };
struct Gemm { const bf16_t* A; const bf16_t* Bt; int M, N, K; };
struct StaticOrder {
    int nM, nN, nwg, G, c; bool rev = false;
    __host__ __device__ void init(int nM_, int nN_, int G_, int c_) { nM = nM_; nN = nN_; nwg = nM * nN; G = G_; c = c_; }
    __host__ __device__ bool next(int i, Unit& u) const {
        const long L = (long)i * G + c; if (L >= nwg) return false;
        int wgid = rev ? (int)(nwg - 1 - L) : (int)L; { const int q = nwg / NXCD, r = nwg % NXCD, xcd = wgid % NXCD, off = wgid / NXCD; wgid = (xcd < r ? xcd * (q + 1) : r * (q + 1) + (xcd - r) * q) + off; }
        const int nig = WGM * nN, gid = wgid / nig, fm = gid * WGM, gsz = (nM - fm) < WGM ? (nM - fm) : WGM;
        u.pm = fm + ((wgid % nig) % gsz); u.pn = (wgid % nig) / gsz; u.pb = u.pn; u.po = u.pm; return true;
    }
    __device__ __forceinline__ void a_ready(const Unit&) const {}
    __device__ __forceinline__ void done(const Unit&) const {}
};
template <class Epi, class Sched, bool ALIGN_EPI = false, bool SP2 = false, bool SWAP = false, bool F8 = false>
__device__ __forceinline__ void gemm_phase(PG8_LAS unsigned char* lds, const Gemm g, const Sched& S, const Epi& E, const int tid) {
    const int wid = __builtin_amdgcn_readfirstlane(tid >> 6), lane = tid & 63, wr = wid >> 2, wc = wid & 3, fr = lane & 15, fq = lane >> 4;
    const int K = g.K, nt = F8 ? K / 128 : K / BK;
    unsigned voffA[2], voffB[2];
#pragma unroll
    for (int i = 0; i < 2; ++i) { int R, C; stage_rc(tid * 16 + i * 8192, R, C); const int Rb = Epi::PERM ? ((R & ~31) + perm32(R & 31)) : R;
        voffA[i] = F8 ? (unsigned)(R * K + C * 2) : (unsigned)(R * K + C) * 2u; voffB[i] = F8 ? (unsigned)(Rb * K + C * 2) : (unsigned)(Rb * K + C) * 2u; }
    const size_t kstep = (size_t)(BK * 2);
    const size_t hstep = F8 ? (size_t)HALF * K : (size_t)HALF * K * 2;
    const size_t tstep = 2 * hstep;
    const unsigned ldsw_u = (unsigned)__builtin_amdgcn_readfirstlane((int)((unsigned)(__UINTPTR_TYPE__)lds + (unsigned)wid * 1024u));
    const int aoff = lds_byte(wr * 64 + fr, fq * 8), boff = lds_byte(wc * 32 + fr, fq * 8);
#define PG8_SA(b, h) (((b) * 2 + (h)) * HTB)
#define PG8_SB(b, h) ((4 + (b) * 2 + (h)) * HTB)
#define PG8_STAGE(bufoff, gbase, voff) do { glds_s<(bufoff)>((const void*)(gbase), (voff)[0], ldsw_u); glds_s<(bufoff) + 8192>((const void*)(gbase), (voff)[1], ldsw_u); } while (0)
#define PG8_LDA(dst, b, h) do { if constexpr (F8) { _Pragma("unroll") for (int m = 0; m < 4; ++m) dst##8[m] = ld32(lds + PG8_SA(b, h) + aoff + m * 2048); } else { _Pragma("unroll") for (int m = 0; m < 4; ++m) _Pragma("unroll") for (int k = 0; k < 2; ++k) dst[m][k] = *(const PG8_LAS bf16x8*)(lds + PG8_SA(b, h) + aoff + m * 2048 + k * 1024); } } while (0)
#define PG8_LDB(dst, b, h) do { if constexpr (F8) { _Pragma("unroll") for (int n = 0; n < 2; ++n) dst##8[n] = ld32(lds + PG8_SB(b, h) + boff + n * 2048); } else { _Pragma("unroll") for (int n = 0; n < 2; ++n) _Pragma("unroll") for (int k = 0; k < 2; ++k) dst[n][k] = *(const PG8_LAS bf16x8*)(lds + PG8_SB(b, h) + boff + n * 2048 + k * 1024); } } while (0)
#define PG8_MMA(ai, bj, At, Bt) do { __builtin_amdgcn_s_setprio(1); if constexpr (F8) { _Pragma("unroll") for (int m = 0; m < 4; ++m) _Pragma("unroll") for (int n = 0; n < 2; ++n) \
        acc[ai][bj][m][n] = __builtin_amdgcn_mfma_scale_f32_16x16x128_f8f6f4(Bt##8[n], At##8[m], acc[ai][bj][m][n], 0, 0, 0, 0x7f7f7f7f, 0, 0x7f7f7f7f); } else { \
        _Pragma("unroll") for (int m = 0; m < 4; ++m) _Pragma("unroll") for (int n = 0; n < 2; ++n) _Pragma("unroll") for (int k = 0; k < 2; ++k) \
        acc[ai][bj][m][n] = SWAP ? __builtin_amdgcn_mfma_f32_16x16x32_bf16(At[m][k], Bt[n][k], acc[ai][bj][m][n], 0, 0, 0) : __builtin_amdgcn_mfma_f32_16x16x32_bf16(Bt[n][k], At[m][k], acc[ai][bj][m][n], 0, 0, 0); } __builtin_amdgcn_s_setprio(0); } while (0)
#define PG8_WAIT_V(n) asm volatile("s_waitcnt vmcnt(" #n ")" ::: "memory")
#define PG8_WAIT_L(n) asm volatile("s_waitcnt lgkmcnt(" #n ")" ::: "memory")
#define PG8_BAR __builtin_amdgcn_s_barrier()
#define PG8_SCHED __builtin_amdgcn_sched_barrier(0)
    Unit cur, nxt; int ui = 0;
    if (!S.next(0, cur)) return;
    f32x4 acc[2][2][4][2];
#pragma unroll
    for (int a = 0; a < 2; ++a)
#pragma unroll
        for (int b = 0; b < 2; ++b)
#pragma unroll
            for (int m = 0; m < 4; ++m)
#pragma unroll
                for (int n = 0; n < 2; ++n) acc[a][b][m][n] = (f32x4){0.f, 0.f, 0.f, 0.f};
    bf16x8 At[4][2], B0[2][2], B1[2][2]; i32x8_t At8[4], B08[2], B18[2];
    const char* cA = (const char*)g.A + (size_t)cur.pm * tstep; const char* cB = (const char*)g.Bt + (size_t)cur.pb * tstep;
    S.a_ready(cur);
    if constexpr (SP2) {
        PG8_STAGE(PG8_SB(0, 0), cB, voffB); PG8_STAGE(PG8_SB(0, 1), cB + hstep, voffB); PG8_STAGE(PG8_SA(0, 0), cA, voffA); PG8_STAGE(PG8_SA(0, 1), cA + hstep, voffA);
        if (wr == 1) PG8_BAR;
        PG8_WAIT_V(2); PG8_BAR;
        PG8_STAGE(PG8_SB(1, 0), cB + kstep, voffB); PG8_STAGE(PG8_SA(1, 0), cA + kstep, voffA); PG8_STAGE(PG8_SB(1, 1), cB + hstep + kstep, voffB);
        PG8_WAIT_V(6); PG8_BAR;
    } else {
        PG8_STAGE(PG8_SB(0, 0), cB, voffB); PG8_STAGE(PG8_SA(0, 0), cA, voffA); PG8_STAGE(PG8_SB(0, 1), cB + hstep, voffB); PG8_STAGE(PG8_SA(0, 1), cA + hstep, voffA);
        if (wr == 1) PG8_BAR;
        PG8_WAIT_V(4); PG8_BAR;
        PG8_STAGE(PG8_SB(1, 0), cB + kstep, voffB); PG8_STAGE(PG8_SA(1, 0), cA + kstep, voffA); PG8_STAGE(PG8_SB(1, 1), cB + hstep + kstep, voffB);
        PG8_WAIT_V(6); PG8_BAR;
    }
    for (;;) {
        const bool has_next = S.next(ui + 1, nxt);
        const char* nA = has_next ? (const char*)g.A + (size_t)nxt.pm * tstep : cA; const char* nB = has_next ? (const char*)g.Bt + (size_t)nxt.pb * tstep : cB;
#pragma unroll 1
        for (int t = 0; t < nt; t += 2) {
            const bool last = (t == nt - 2);
            const char* a1 = cA + (size_t)(t + 1) * kstep;
            const char* a2 = last ? nA : cA + (size_t)(t + 2) * kstep; const char* b2 = last ? nB : cB + (size_t)(t + 2) * kstep;
            const char* a3 = a2 + kstep; const char* b3 = b2 + kstep;
            if (last && has_next) S.a_ready(nxt);
            if constexpr (SP2) {
            PG8_LDB(B0, 0, 0); PG8_LDB(B1, 0, 1); PG8_SCHED; PG8_LDA(At, 0, 0); PG8_STAGE(PG8_SA(1, 1), a1 + hstep, voffA);
            PG8_WAIT_V(8); PG8_WAIT_L(0); PG8_BAR; PG8_MMA(0, 0, At, B0); PG8_MMA(0, 1, At, B1); PG8_BAR; PG8_SCHED;
            PG8_LDA(At, 0, 1); PG8_STAGE(PG8_SB(0, 0), b2, voffB); PG8_STAGE(PG8_SB(0, 1), b2 + hstep, voffB); PG8_STAGE(PG8_SA(0, 0), a2, voffA);
            PG8_WAIT_V(8); PG8_WAIT_L(0); PG8_BAR; PG8_MMA(1, 0, At, B0); PG8_MMA(1, 1, At, B1); PG8_BAR; PG8_SCHED;
            PG8_LDB(B0, 1, 0); PG8_LDB(B1, 1, 1); PG8_SCHED; PG8_LDA(At, 1, 0); PG8_STAGE(PG8_SA(0, 1), a2 + hstep, voffA);
            PG8_WAIT_V(8); PG8_WAIT_L(0); PG8_BAR; PG8_MMA(0, 0, At, B0); PG8_MMA(0, 1, At, B1); PG8_BAR; PG8_SCHED;
            PG8_LDA(At, 1, 1); PG8_STAGE(PG8_SB(1, 0), b3, voffB); PG8_STAGE(PG8_SB(1, 1), b3 + hstep, voffB); PG8_STAGE(PG8_SA(1, 0), a3, voffA);
            PG8_WAIT_V(8); PG8_WAIT_L(0); PG8_BAR; PG8_MMA(1, 0, At, B0); PG8_MMA(1, 1, At, B1); PG8_BAR; PG8_SCHED;
            } else {
            PG8_LDB(B0, 0, 0); PG8_SCHED; PG8_LDA(At, 0, 0); PG8_STAGE(PG8_SA(1, 1), a1 + hstep, voffA);
            PG8_WAIT_L(8); PG8_BAR; PG8_WAIT_L(0); PG8_MMA(0, 0, At, B0); PG8_BAR; PG8_SCHED;
            PG8_LDB(B1, 0, 1); PG8_STAGE(PG8_SB(0, 0), b2, voffB);
            PG8_BAR; PG8_WAIT_L(0); PG8_MMA(0, 1, At, B1); PG8_BAR;
            PG8_LDA(At, 0, 1); PG8_STAGE(PG8_SA(0, 0), a2, voffA);
            PG8_BAR; PG8_WAIT_L(0); PG8_MMA(1, 0, At, B0); PG8_BAR; PG8_SCHED;
            PG8_STAGE(PG8_SB(0, 1), b2 + hstep, voffB);
            PG8_WAIT_V(6); PG8_BAR; PG8_MMA(1, 1, At, B1); PG8_BAR;
            PG8_LDB(B0, 1, 0); PG8_SCHED; PG8_LDA(At, 1, 0); PG8_STAGE(PG8_SA(0, 1), a2 + hstep, voffA);
            PG8_WAIT_L(8); PG8_BAR; PG8_WAIT_L(0); PG8_MMA(0, 0, At, B0); PG8_BAR; PG8_SCHED;
            PG8_LDB(B1, 1, 1); PG8_STAGE(PG8_SB(1, 0), b3, voffB);
            PG8_BAR; PG8_WAIT_L(0); PG8_MMA(0, 1, At, B1); PG8_BAR;
            PG8_LDA(At, 1, 1); PG8_STAGE(PG8_SA(1, 0), a3, voffA);
            PG8_BAR; PG8_WAIT_L(0); PG8_MMA(1, 0, At, B0); PG8_BAR; PG8_SCHED;
            PG8_STAGE(PG8_SB(1, 1), b3 + hstep, voffB);
            PG8_WAIT_V(6); PG8_BAR; PG8_MMA(1, 1, At, B1); PG8_BAR;
            }
        }
        if constexpr (ALIGN_EPI) { if (wr == 0) PG8_BAR; }
        if constexpr (!Epi::AFTER_DRAIN) { E(acc, cur, wr, wc, fr, fq); S.done(cur); }
        if (!has_next) break;
#pragma unroll
        for (int a = 0; a < 2; ++a)
#pragma unroll
            for (int b = 0; b < 2; ++b)
#pragma unroll
                for (int m = 0; m < 4; ++m)
#pragma unroll
                    for (int n = 0; n < 2; ++n) acc[a][b][m][n] = (f32x4){0.f, 0.f, 0.f, 0.f};
        cur = nxt; cA = nA; cB = nB; ++ui;
        if constexpr (ALIGN_EPI) { if (wr == 1) PG8_BAR; }
    }
    PG8_WAIT_V(0);
    if constexpr (!ALIGN_EPI) { if (wr == 0) PG8_BAR; }
    PG8_BAR;
    if constexpr (Epi::AFTER_DRAIN) { E.fused(acc, cur, wr, wc, fr, fq, lds, wid, lane); S.done(cur); }
#undef PG8_SA
#undef PG8_SB
#undef PG8_STAGE
#undef PG8_LDA
#undef PG8_LDB
#undef PG8_MMA
#undef PG8_WAIT_V
#undef PG8_WAIT_L
#undef PG8_BAR
#undef PG8_SCHED
}
}

struct Args { const float* in[24]; float* out; unsigned char* ws; int ph_lo, ph_hi; };
struct Frame {
    LAS unsigned char* lds; unsigned char* ws; float* out;
    int tid, lane, wave, gw, NGW, G, blk;
};
typedef const __attribute__((address_space(4))) Args* KArgs;
__device__ __forceinline__ KArgs kargs() { KArgs p = (KArgs)__builtin_amdgcn_kernarg_segment_ptr(); asm volatile("" : "+s"(p)); return p; }
__device__ __forceinline__ Frame relaunder(const Frame& F0) {
    Frame F = F0;
    { KArgs a = kargs(); F.ws = a->ws; F.out = a->out; }
    asm volatile("" : "+s"(F.wave), "+s"(F.gw), "+s"(F.blk));
    F.lane = lane_id_fresh(); F.tid = F.wave * 64 + F.lane;
    return F;
}
enum { I_X = 0, I_META, I_RELB, I_NMIX, I_WIN, I_PGW, I_PSC, I_LQ1, I_LK1, I_LQ2, I_LK2, I_SUBLN, I_WPU, I_WAU, I_WOUT, I_NFFN, I_DG, I_DU, I_DD, I_ROUTER, I_MG, I_MU, I_MD, I_FNORM };

template <int MODE> struct G16Acc { static constexpr int NA = (MODE == 1) ? 4 : 2; f32x4 a[NA]; };
template <int MODE>
__device__ __forceinline__ void g16_core(const bf16* __restrict__ A, int lda, const bf16* __restrict__ Bt, int ldb, int kb, int ke, int m0, int cg, int lane, G16Acc<MODE>& R) {
    const int fr = lane & 15, fq = lane >> 4;
    constexpr int NA = G16Acc<MODE>::NA;
#pragma unroll
    for (int j = 0; j < NA; ++j) R.a[j] = (f32x4){0.f, 0.f, 0.f, 0.f};
    const bf16* ap = A + (size_t)(m0 + fr) * lda + 8 * fq;
    const bf16* bp[NA];
    const int n0 = 32 * cg;
    if constexpr (MODE == 0) { const int pr = 8 * (fr >> 2) + (fr & 3);
#pragma unroll
        for (int j = 0; j < 2; ++j) bp[j] = Bt + (size_t)(n0 + pr + 4 * j) * ldb + 8 * fq; }
    else if constexpr (MODE == 1) { const int pr = 8 * (fr >> 2) + (fr & 3); const int gb = 256 * (n0 >> 7) + (n0 & 127);
#pragma unroll
        for (int j = 0; j < 2; ++j) { bp[j] = Bt + (size_t)(gb + pr + 4 * j) * ldb + 8 * fq; bp[2 + j] = Bt + (size_t)(gb + 128 + pr + 4 * j) * ldb + 8 * fq; } }
    else {
#pragma unroll
        for (int j = 0; j < 2; ++j) bp[j] = Bt + (size_t)(n0 + 16 * j + fr) * ldb + 8 * fq; }
#pragma unroll 2
    for (int k0 = kb; k0 < ke; k0 += 64) {
        bf16x8 a[2], b[2][NA];
#pragma unroll
        for (int q = 0; q < 2; ++q) { a[q] = *(const bf16x8*)(ap + k0 + 32 * q);
#pragma unroll
            for (int j = 0; j < NA; ++j) b[q][j] = *(const bf16x8*)(bp[j] + k0 + 32 * q); }
        __builtin_amdgcn_sched_barrier(0);
#pragma unroll
        for (int q = 0; q < 2; ++q)
#pragma unroll
            for (int j = 0; j < NA; ++j) {
                if (MODE == 2) R.a[j] = __builtin_amdgcn_mfma_f32_16x16x32_bf16(a[q], b[q][j], R.a[j], 0, 0, 0);
                else R.a[j] = __builtin_amdgcn_mfma_f32_16x16x32_bf16(b[q][j], a[q], R.a[j], 0, 0, 0);
            }
    }
}
template <int MODE, class Epi>
__device__ __forceinline__ void g16_epi(const G16Acc<MODE>& R, int cg, int lane, const Epi& E, int rowout0) {
    const int fr = lane & 15, fq = lane >> 4, n0 = 32 * cg;
    if constexpr (MODE == 0) E.put8(rowout0 + fr, n0 + 8 * fq, R.a[0], R.a[1]);
    else if constexpr (MODE == 1) E.put8x2(rowout0 + fr, n0 + 8 * fq, R.a[0], R.a[1], R.a[2], R.a[3]);
    else {
#pragma unroll
        for (int j = 0; j < 2; ++j) E.putT(rowout0 + 4 * fq, n0 + 16 * j + fr, R.a[j]); }
}
template <int MODE, class Epi>
__device__ __forceinline__ void g16_item(const bf16* __restrict__ A, int lda, const bf16* __restrict__ Bt, int ldb, int K, int m0, int cg, int lane, const Epi& E, int rowout0) {
    G16Acc<MODE> R; g16_core<MODE>(A, lda, Bt, ldb, 0, K, m0, cg, lane, R); g16_epi<MODE>(R, cg, lane, E, rowout0);
}
template <int MODE, class Epi>
__device__ __forceinline__ void g16_phase(const Frame& F, const bf16* A, int lda, const bf16* Bt, int ldb, int K, int nstrips, int ncg, const Epi& E) {
    const long tot = (long)nstrips * ncg;
    for (long it = F.gw; it < tot; it += F.NGW) { const int strip = (int)(it / ncg), cg = (int)(it % ncg); g16_item<MODE>(A, lda, Bt, ldb, K, strip * 16, cg, F.lane, E, strip * 16); }
}
template <int MODE, class Epi>
__device__ __forceinline__ void g16_meta(const Frame& F, const bf16* A, int lda, const bf16* Bt, int ldb, int K, int ncg, const Epi& E) {
    constexpr int NA = G16Acc<MODE>::NA;
    LAS f32x4* part = (LAS f32x4*)(F.lds);
    for (int it = F.blk; it < ncg; it += F.G) {
        const int kw = K / NWAVES;
        G16Acc<MODE> R; g16_core<MODE>(A, lda, Bt, ldb, F.wave * kw, (F.wave + 1) * kw, 0, it, F.lane, R);
#pragma unroll
        for (int j = 0; j < NA; ++j) part[(F.wave * NA + j) * 64 + F.lane] = R.a[j];
        __syncthreads();
        if (F.wave == 0) {
#pragma unroll
            for (int j = 0; j < NA; ++j) { f32x4 sum = part[j * 64 + F.lane];
#pragma unroll
                for (int w = 1; w < NWAVES; ++w) sum += part[(w * NA + j) * 64 + F.lane];
                R.a[j] = sum; }
            g16_epi<MODE>(R, it, F.lane, E, 0);
        }
        __syncthreads();
    }
}

struct EpiInProj {
    bf16 *U, *Q, *Kb, *G0, *G1;
    __device__ __forceinline__ void put8(int row, int col, f32x4 lo, f32x4 hi) const {
        if (col < 512) { *(u32x4*)(U + ((size_t)(row >> 13) * UROWS + NMETA + (row & (S - 1))) * 512 + col) = pack8(lo, hi); }
        else if (col < 1536) {
            const int isk = col >= 1024; const int c = col - (isk ? 1024 : 512); const int hh = c >> 7, cc = (c >> 6) & 1, dd = c & 63; const int b = row >> 13, s = row & (S - 1);
            if (!isk) { *(u32x4*)(Q + ((size_t)(((b * NH + hh) * 2 + cc)) * S + s) * 64 + dd) = pack8(lo * C2, hi * C2); }
            else { *(u32x4*)(Kb + ((size_t)(((b * NH + hh) * 2 + cc)) * KROWS + 64 + s) * 64 + dd) = pack8(lo, hi); }
        } else {
            const int g = col - 1536;
            *(u32x4*)(G0 + (size_t)row * 2048 + g) = pack8(lo, hi);
        }
    }
};
struct EpiV {
    bf16* VT;
    __device__ __forceinline__ void putT(int row0, int col, f32x4 v) const {
        const int hh = col >> 7, d = col & 127, b = row0 >> 13, s0 = row0 & (S - 1);
        u32x2 w; w.x = cvtpk(v[0], v[1]); w.y = cvtpk(v[2], v[3]);
        *(u32x2*)(VT + ((size_t)((b * NH + hh) * 128 + d)) * KROWS + 64 + vperm16(s0)) = w;
    }
};
struct EpiInProjMeta {
    float* MPROJ; bf16* Kb; bf16* U;
    __device__ __forceinline__ void put8(int t, int col, f32x4 lo, f32x4 hi) const {
        const int oc = (col < 1536) ? col : col + 512;
        if (col < 512) { const u32x4 w = pack8(lo, hi);
#pragma unroll
            for (int b = 0; b < NB; ++b) *(u32x4*)(U + ((size_t)b * UROWS + t) * 512 + col) = w; }
        *(f32x4*)(MPROJ + (size_t)t * 4096 + oc) = lo; *(f32x4*)(MPROJ + (size_t)t * 4096 + oc + 4) = hi;
        if (col >= 1024 && col < 1536) { const int c = col - 1024; const int hh = c >> 7, cc = (c >> 6) & 1, dd = c & 63; const u32x4 w = pack8(lo, hi);
#pragma unroll
            for (int b = 0; b < NB; ++b) *(u32x4*)(Kb + ((size_t)(((b * NH + hh) * 2 + cc)) * KROWS + t) * 64 + dd) = w; }
    }
};
struct EpiVMeta {
    float* MPROJ; bf16* VT;
    __device__ __forceinline__ void putT(int t0, int col, f32x4 v) const {
#pragma unroll
        for (int r = 0; r < 4; ++r) MPROJ[(size_t)(t0 + r) * 4096 + 1536 + col] = v[r];
        const int hh = col >> 7, d = col & 127; u32x2 w; w.x = cvtpk(v[0], v[1]); w.y = cvtpk(v[2], v[3]);
#pragma unroll
        for (int b = 0; b < NB; ++b) *(u32x2*)(VT + ((size_t)((b * NH + hh) * 128 + d)) * KROWS + vperm16(t0)) = w;
    }
};
struct EpiP {
    const bf16* G0; bf16* TMP;
    static constexpr int NLOAD = 1;
    __device__ __forceinline__ void pre(int row, int col, u32x4 (&d)[1]) const { d[0] = __builtin_nontemporal_load((const u32x4*)(G0 + (size_t)row * 2048 + col)); }
    __device__ __forceinline__ void put8p(int row, int col, f32x4 lo, f32x4 hi, const u32x4 (&d)[1]) const {
        f32x4 ga, gb; unpack8(d[0], ga, gb); ga = sig4(ga); gb = sig4(gb);
        *(u32x4*)(TMP + (size_t)row * D + col) = pack8(ga * lo, gb * hi);
    }
};
struct EpiQm {
    const bf16* G1; const bf16* TMP; bf16* MG;
    static constexpr int NLOAD = 2;
    __device__ __forceinline__ void pre(int row, int col, u32x4 (&d)[2]) const { d[0] = __builtin_nontemporal_load((const u32x4*)(G1 + (size_t)row * 2048 + 1024 + col)); d[1] = *(const u32x4*)(TMP + (size_t)row * D + col); }
    __device__ __forceinline__ void put8p(int row, int col, f32x4 lo, f32x4 hi, const u32x4 (&d)[2]) const {
        f32x4 ga, gb, ta, tb; unpack8(d[0], ga, gb); ga = sig4(ga); gb = sig4(gb); unpack8(d[1], ta, tb);
        *(u32x4*)(MG + (size_t)row * D + col) = pack8(ta + ga * lo, tb + gb * hi);
    }
};
struct EpiPMeta {
    const float* MPROJ; float* MTMP;
    __device__ __forceinline__ void put8(int t, int col, f32x4 lo, f32x4 hi) const {
        const f32x4 ga = sig4(*(const f32x4*)(MPROJ + (size_t)t * 4096 + 2048 + col)), gb = sig4(*(const f32x4*)(MPROJ + (size_t)t * 4096 + 2048 + col + 4));
        *(f32x4*)(MTMP + (size_t)t * D + col) = ga * lo; *(f32x4*)(MTMP + (size_t)t * D + col + 4) = gb * hi;
    }
};
struct EpiQMeta {
    const float* MPROJ; const float* MTMP; bf16* MMERG;
    __device__ __forceinline__ void put8(int t, int col, f32x4 lo, f32x4 hi) const {
        const f32x4 ga = sig4(*(const f32x4*)(MPROJ + (size_t)t * 4096 + 3072 + col)), gb = sig4(*(const f32x4*)(MPROJ + (size_t)t * 4096 + 3072 + col + 4));
        const f32x4 ta = *(const f32x4*)(MTMP + (size_t)t * D + col), tb = *(const f32x4*)(MTMP + (size_t)t * D + col + 4);
        *(u32x4*)(MMERG + (size_t)t * D + col) = pack8(ta + ga * lo, tb + gb * hi);
    }
};
struct EpiRes {
    const float* res; float* out;
    __device__ __forceinline__ void put8(int row, int col, f32x4 lo, f32x4 hi) const {
        const f32x4 ra = *(const f32x4*)(res + (size_t)row * D + col), rb = *(const f32x4*)(res + (size_t)row * D + col + 4);
        *(f32x4*)(out + (size_t)row * D + col) = ra + lo; *(f32x4*)(out + (size_t)row * D + col + 4) = rb + hi;
    }
};
struct EpiResX {
    const float* res; bf16* out;
    static constexpr int NLOAD = 2;
    __device__ __forceinline__ void pre(int row, int col, u32x4 (&d)[2]) const { d[0] = __builtin_nontemporal_load((const u32x4*)(res + (size_t)row * D + col)); d[1] = __builtin_nontemporal_load((const u32x4*)(res + (size_t)row * D + col + 4)); }
    __device__ __forceinline__ void put8p(int row, int col, f32x4 lo, f32x4 hi, const u32x4 (&d)[2]) const {
        const f32x4 ra = __builtin_bit_cast(f32x4, d[0]), rb = __builtin_bit_cast(f32x4, d[1]);
        *(u32x4*)(out + (size_t)row * D + col) = pack8(ra + lo, rb + hi);
    }
};
struct EpiResH {
    bf16* h;
    static constexpr int NLOAD = 1;
    __device__ __forceinline__ void pre(int row, int col, u32x4 (&d)[1]) const { d[0] = *(const u32x4*)(h + (size_t)row * D + col); }
    __device__ __forceinline__ void put8p(int row, int col, f32x4 lo, f32x4 hi, const u32x4 (&d)[1]) const {
        f32x4 ra, rb; unpack8(d[0], ra, rb);
        *(u32x4*)(h + (size_t)row * D + col) = pack8(ra + lo, rb + hi);
    }
};
__device__ __forceinline__ f32x4 swiglu4(f32x4 g, f32x4 u) { return (f32x4){g[0] * sigmoidf_(g[0]) * u[0], g[1] * sigmoidf_(g[1]) * u[1], g[2] * sigmoidf_(g[2]) * u[2], g[3] * sigmoidf_(g[3]) * u[3]}; }
struct EpiGU {
    bf16* ACT; int row_off;
    __device__ __forceinline__ void put8x2(int row, int col, f32x4 g0, f32x4 g1, f32x4 u0, f32x4 u1) const {
        *(u32x4*)(ACT + (size_t)(row - row_off) * DFF + col) = pack8(swiglu4(g0, u0), swiglu4(g1, u1));
    }
};
struct EpiY {
    bf16* Y;
    __device__ __forceinline__ void put8(int row, int col, f32x4 lo, f32x4 hi) const { *(u32x4*)(Y + (size_t)row * D + col) = pack8(lo, hi); }
};


template <class E, class = void> struct epi_nload { static constexpr int v = 0; };
template <class E> struct epi_nload<E, decltype((void)E::NLOAD)> { static constexpr int v = E::NLOAD; };
template <int MODE, class E> struct PgEpi {
    static constexpr bool PERM = (MODE != 2), AFTER_DRAIN = false;
    E e;
    __device__ __forceinline__ void operator()(const f32x4 (&acc)[2][2][4][2], const pg8::Unit& u, int wr, int wc, int fr, int fq) const {
        { const int le = lane_id_fresh(); fr = le & 15; fq = le >> 4; }
        if constexpr (MODE == 0 && epi_nload<E>::v > 0) {
            constexpr int NL = epi_nload<E>::v;
            u32x4 pre[2][4][NL];
            const int row00 = u.po * 256 + wr * 64 + fr, col00 = u.pn * 256 + wc * 32 + 8 * fq;
#pragma unroll
            for (int j = 0; j < 4; ++j) e.pre(row00 + (j >> 3) * 128 + ((j >> 1) & 3) * 16, col00 + (j & 1) * 128, pre[0][j]);
#pragma unroll
            for (int g = 0; g < 4; ++g) {
                if (g + 1 < 4) {
#pragma unroll
                    for (int j = 0; j < 4; ++j) { const int idx = 4 * (g + 1) + j; e.pre(row00 + (idx >> 3) * 128 + ((idx >> 1) & 3) * 16, col00 + (idx & 1) * 128, pre[(g + 1) & 1][j]); } }
                __builtin_amdgcn_sched_barrier(0);
#pragma unroll
                for (int j = 0; j < 4; ++j) { const int idx = 4 * g + j; e.put8p(row00 + (idx >> 3) * 128 + ((idx >> 1) & 3) * 16, col00 + (idx & 1) * 128, acc[idx >> 3][idx & 1][(idx >> 1) & 3][0], acc[idx >> 3][idx & 1][(idx >> 1) & 3][1], pre[g & 1][j]); }
                __builtin_amdgcn_sched_barrier(0);
            }
        } else
#pragma unroll
        for (int ai = 0; ai < 2; ++ai)
#pragma unroll
            for (int m = 0; m < 4; ++m) {
                if constexpr (MODE == 0) { const int row = u.po * 256 + ai * 128 + wr * 64 + m * 16 + fr;
#pragma unroll
                    for (int bj = 0; bj < 2; ++bj) e.put8(row, u.pn * 256 + bj * 128 + wc * 32 + 8 * fq, acc[ai][bj][m][0], acc[ai][bj][m][1]); }
                else if constexpr (MODE == 1) { const int row = u.po * 256 + ai * 128 + wr * 64 + m * 16 + fr;
                    e.put8x2(row, u.pn * 128 + wc * 32 + 8 * fq, acc[ai][0][m][0], acc[ai][0][m][1], acc[ai][1][m][0], acc[ai][1][m][1]); }
                else { const int row0 = u.po * 256 + ai * 128 + wr * 64 + m * 16 + 4 * fq;
#pragma unroll
                    for (int bj = 0; bj < 2; ++bj)
#pragma unroll
                        for (int n = 0; n < 2; ++n) e.putT(row0, u.pn * 256 + bj * 128 + wc * 32 + 16 * n + fr, acc[ai][bj][m][n]); }
            }
    }
};
struct MoeOrder {
    pg8::StaticOrder so; int p0; const int* PE; int nbt; int a_abs;
    __device__ __forceinline__ bool next(int i, pg8::Unit& u) const {
        if (!so.next(i, u)) return false;
        const int rel = u.pm, e = __builtin_amdgcn_readfirstlane(PE[p0 + rel]); u.pb = e * nbt + u.pn; u.pm = a_abs ? p0 + rel : rel; u.po = a_abs ? rel : p0 + rel; return true; }
    __device__ __forceinline__ void a_ready(const pg8::Unit&) const {}
    __device__ __forceinline__ void done(const pg8::Unit&) const {}
};
template <int MODE, class E, class Sched, bool F8 = false>
__device__ __forceinline__ void pg_gemm(const Frame& F, const bf16* A, const bf16* Bt, int K, const Sched& S, const E& e) {
    pg8::Gemm g{A, Bt, 0, 0, K}; PgEpi<MODE, E> pe{e};
    pg8::gemm_phase<PgEpi<MODE, E>, Sched, true, true, MODE == 2, F8>(F.lds, g, S, pe, F.tid);
}

__device__ __forceinline__ void tr_item(const float* __restrict__ W, int ldw, int col0, int K, int ncols, bf16* WT, int row0, int gu, LAS float* scr, int item, int lane) {
    const int nblk = ncols / 32, kb = item / nblk, nb = item % nblk, k0 = 64 * kb, n0 = 32 * nb;
    float wv[32];
#pragma unroll
    for (int i = 0; i < 32; ++i) { const int kk = 2 * i + (lane >> 5); wv[i] = W[(size_t)(k0 + kk) * ldw + col0 + n0 + (lane & 31)]; }
#pragma unroll
    for (int i = 0; i < 32; ++i) { const int kk = 2 * i + (lane >> 5); scr[kk * 33 + (lane & 31)] = wv[i]; }
    LDS_WAIT(); asm volatile("" ::: "memory");
    const int drow0 = gu ? (256 * (n0 >> 7) + (n0 & 127) + row0) : (row0 + n0);
    const int c = lane & 7;
#pragma unroll
    for (int j = 0; j < 4; ++j) { const int n = (lane >> 3) + 8 * j; const LAS float* s = scr + (8 * c) * 33 + n;
        u32x4 o; o.x = cvtpk(s[0 * 33], s[1 * 33]); o.y = cvtpk(s[2 * 33], s[3 * 33]); o.z = cvtpk(s[4 * 33], s[5 * 33]); o.w = cvtpk(s[6 * 33], s[7 * 33]);
        *(u32x4*)(WT + (size_t)(drow0 + n) * K + k0 + 8 * c) = o; }
    LDS_WAIT(); asm volatile("" ::: "memory");
}
__device__ __forceinline__ void tr_item8(const float* __restrict__ W, int ldw, int K, int ncols, unsigned char* WT, int row0, int gu, LAS float* scr, int item, int lane, float sc) {
    const int nblk = ncols / 32, kb = item / nblk, nb = item % nblk, k0 = 64 * kb, n0 = 32 * nb;
    float wv[32];
#pragma unroll
    for (int i = 0; i < 32; ++i) { const int kk = 2 * i + (lane >> 5); wv[i] = W[(size_t)(k0 + kk) * ldw + n0 + (lane & 31)]; }
#pragma unroll
    for (int i = 0; i < 32; ++i) { const int kk = 2 * i + (lane >> 5); scr[kk * 33 + (lane & 31)] = wv[i] * sc; }
    LDS_WAIT(); asm volatile("" ::: "memory");
    const int drow0 = gu ? (256 * (n0 >> 7) + (n0 & 127) + row0) : (row0 + n0);
    const int c = lane & 7;
#pragma unroll
    for (int j = 0; j < 4; ++j) { const int n = (lane >> 3) + 8 * j; const LAS float* s = scr + (8 * c) * 33 + n;
        u32x2 o; o.x = pk4_fp8(s[0 * 33], s[1 * 33], s[2 * 33], s[3 * 33]); o.y = pk4_fp8(s[4 * 33], s[5 * 33], s[6 * 33], s[7 * 33]);
        *(u32x2*)(WT + (size_t)(drow0 + n) * K + k0 + 8 * c) = o; }
    LDS_WAIT(); asm volatile("" ::: "memory");
}
__device__ __forceinline__ float row_rs(const f32x4 (&v)[4]) {
    float s = 0.f;
#pragma unroll
    for (int j = 0; j < 4; ++j) s += (v[j][0] * v[j][0] + v[j][1] * v[j][1]) + (v[j][2] * v[j][2] + v[j][3] * v[j][3]);
    return 1.0f / sqrtf(wave_sum(s) * (1.0f / D) + RMS_EPS);
}
__device__ __forceinline__ int rowcol(int lane, int j) { return ((j >> 1) << 9) + 8 * lane + 4 * (j & 1); }
__device__ __forceinline__ void load_row_b(const bf16* src, int lane, f32x4 (&v)[4]) { unpack8(*(const u32x4*)(src + 8 * lane), v[0], v[1]); unpack8(*(const u32x4*)(src + 512 + 8 * lane), v[2], v[3]); }
__device__ __forceinline__ void norm_row_b(const bf16* src, const float* gain, bf16* dst, int lane) {
    f32x4 v[4]; load_row_b(src, lane, v);
    const float rs = row_rs(v);
    f32x4 o[4];
#pragma unroll
    for (int j = 0; j < 4; ++j) o[j] = v[j] * rs * *(const f32x4*)(gain + rowcol(lane, j));
    *(u32x4*)(dst + 8 * lane) = pack8(o[0], o[1]); *(u32x4*)(dst + 512 + 8 * lane) = pack8(o[2], o[3]);
}
__device__ __forceinline__ void norm_row(const float* src, const float* gain, bf16* dst, int lane) {
    const f32x4* xr = (const f32x4*)src + lane; f32x4 v[4];
#pragma unroll
    for (int j = 0; j < 4; ++j) v[j] = xr[64 * j];
    const float rs = row_rs(v);
#pragma unroll
    for (int j = 0; j < 4; ++j) { const f32x4 g = ((const f32x4*)gain)[lane + 64 * j]; const f32x4 o = v[j] * rs * g; u32x2 w; w.x = cvtpk(o[0], o[1]); w.y = cvtpk(o[2], o[3]); *((u32x2*)dst + lane + 64 * j) = w; }
}
__device__ __forceinline__ void zero_meta_tiles(const Frame& F) {
    bf16* Kb = (bf16*)(F.ws + WS_K); bf16* VT = (bf16*)(F.ws + WS_VT);
    const int gt = F.blk * NTHR + F.tid, NT = F.G * NTHR;
    unsigned zz = 0u; asm volatile("" : "+v"(zz)); const u32x4 z = (u32x4){zz, zz, zz, zz};
    for (int i = gt; i < NB * NH * 2 * 512; i += NT) { const int t = i >> 9, o = i & 511; *(u32x4*)(Kb + (size_t)t * KROWS * 64 + o * 8) = z; }
    for (int i = gt; i < NB * NH * 128 * 8; i += NT) { const int r = i >> 3, o = i & 7; *(u32x4*)(VT + (size_t)r * KROWS + o * 8) = z; }
}
__device__ __forceinline__ float lambda_init(int layer) { return layer == 0 ? 0.2f : 0.35550906f; }

struct TrSrc { const float* W; int ldw, col0, K, ncols, row0, gu; void* WT; };
__device__ __forceinline__ void tr_load(const TrSrc& s, int item, int lane, float (&wv)[32]) {
    const int nblk = s.ncols / 32, kb = item / nblk, nb = item % nblk, k0 = 64 * kb, n0 = 32 * nb;
    const float* p = s.W + (size_t)(k0 + (lane >> 5)) * s.ldw + s.col0 + n0 + (lane & 31);
#pragma unroll
    for (int i = 0; i < 32; ++i) wv[i] = __builtin_nontemporal_load(p + (size_t)(2 * i) * s.ldw);
}
template <bool F8> __device__ __forceinline__ void tr_store(const TrSrc& s, int item, int lane, const float (&wv)[32], LAS float* scr, float sc) {
    const int nblk = s.ncols / 32, kb = item / nblk, nb = item % nblk, k0 = 64 * kb, n0 = 32 * nb, K = s.K;
#pragma unroll
    for (int i = 0; i < 32; ++i) { const int kk = 2 * i + (lane >> 5); scr[kk * 33 + (lane & 31)] = F8 ? wv[i] * sc : wv[i]; }
    LDS_WAIT(); asm volatile("" ::: "memory");
    const int drow0 = s.gu ? (256 * (n0 >> 7) + (n0 & 127) + s.row0) : (s.row0 + n0);
    const int c = lane & 7;
#pragma unroll
    for (int j = 0; j < 4; ++j) { const int n = (lane >> 3) + 8 * j; const LAS float* q = scr + (8 * c) * 33 + n;
        if constexpr (F8) { u32x2 o; o.x = pk4_fp8(q[0 * 33], q[1 * 33], q[2 * 33], q[3 * 33]); o.y = pk4_fp8(q[4 * 33], q[5 * 33], q[6 * 33], q[7 * 33]);
            *(u32x2*)((unsigned char*)s.WT + (size_t)(drow0 + n) * K + k0 + 8 * c) = o; }
        else { u32x4 o; o.x = cvtpk(q[0 * 33], q[1 * 33]); o.y = cvtpk(q[2 * 33], q[3 * 33]); o.z = cvtpk(q[4 * 33], q[5 * 33]); o.w = cvtpk(q[6 * 33], q[7 * 33]);
            *(u32x4*)((bf16*)s.WT + (size_t)(drow0 + n) * K + k0 + 8 * c) = o; } }
    LDS_WAIT(); asm volatile("" ::: "memory");
}
__device__ __forceinline__ void ph_prologue(const Frame& F0, KArgs a) {
    const Frame F = relaunder(F0);
    LAS float* scr = (LAS float*)(F.lds + F.wave * 16384);
    constexpr int J1 = 16 * 48, J2 = 16 * 64, J3 = 16 * 16, J4 = 8 * 32, J5 = 16 * 32, JL = J1 + J2 + J3 + J4 + J5;
    constexpr int J6 = 16 * 112, J8 = 56 * 32, JWC = 1024;
    constexpr int NJ = 2 * JL + 2 * J6 + J8 + 2 * JWC;
    bf16* HN = (bf16*)(F.ws + WS_HN);
    f32x4 gx[4];
#pragma unroll
    for (int j = 0; j < 4; ++j) gx[j] = ((const f32x4*)a->in[I_NMIX])[F.lane + 64 * j];
    const f32x4* x0 = (const f32x4*)a->in[I_X] + F.lane; f32x4 cur[4];
#pragma unroll
    for (int j = 0; j < 4; ++j) cur[j] = x0[(size_t)F.gw * 256 + 64 * j];
    int nm_ = F.gw;
    auto norm_rows = [&](int cnt) {
#pragma unroll 1
        for (int q = 0; q < cnt && nm_ < M; ++q) { const int m = nm_; const int nm = (m + F.NGW < M) ? m + F.NGW : m; f32x4 nxt[4];
#pragma unroll
            for (int j = 0; j < 4; ++j) nxt[j] = __builtin_nontemporal_load(x0 + (size_t)nm * 256 + 64 * j);
            const float rs = row_rs(cur); bf16* dst = HN + (size_t)m * D;
#pragma unroll
            for (int j = 0; j < 4; ++j) { const f32x4 o = cur[j] * rs * gx[j]; u32x2 w; w.x = cvtpk(o[0], o[1]); w.y = cvtpk(o[2], o[3]); *((u32x2*)dst + F.lane + 64 * j) = w; cur[j] = nxt[j]; }
            nm_ += F.NGW; } };
    constexpr int NJT = 2 * JL + 2 * J6 + J8;
#pragma unroll 1
    for (int it = F.gw; it < NJT; it += F.NGW) {
        int r = it; TrSrc t; t.gu = 0; t.row0 = 0; t.col0 = 0;
        if (r < 2 * JL) { const int l = r / JL; r %= JL;
            const float* win = a->in[I_WIN] + (size_t)l * D * 4096;
            if (r < J1) { t.W = win; t.ldw = 4096; t.K = D; t.ncols = 1536; t.WT = F.ws + WS_WIN + l * WIN_L; }
            else if (r < J1 + J2) { r -= J1; t.W = win; t.ldw = 4096; t.col0 = 2048; t.K = D; t.ncols = 2048; t.WT = F.ws + WS_WIN + l * WIN_L; t.row0 = 1536; }
            else if (r < J1 + J2 + J3) { r -= J1 + J2; t.W = win; t.ldw = 4096; t.col0 = 1536; t.K = D; t.ncols = 512; t.WT = F.ws + WS_WV + l * WV_L; }
            else if (r < J1 + J2 + J3 + J4) { r -= J1 + J2 + J3; t.W = a->in[I_WAU] + (size_t)l * 512 * D; t.ldw = D; t.K = 512; t.ncols = D; t.WT = F.ws + WS_WAU + l * WC_L; }
            else { r -= J1 + J2 + J3 + J4; t.W = a->in[I_WOUT] + (size_t)l * D * D; t.ldw = D; t.K = D; t.ncols = D; t.WT = F.ws + WS_WOUT + l * WOUT_L; } }
        else { r -= 2 * JL;
            if (r < J6) { t.W = a->in[I_DG]; t.ldw = DFF; t.K = D; t.ncols = DFF; t.WT = F.ws + WS_WGU; t.gu = 1; }
            else if (r < 2 * J6) { r -= J6; t.W = a->in[I_DU]; t.ldw = DFF; t.K = D; t.ncols = DFF; t.WT = F.ws + WS_WGU; t.row0 = 128; t.gu = 1; }
            else { r -= 2 * J6; t.W = a->in[I_DD]; t.ldw = D; t.K = DFF; t.ncols = D; t.WT = F.ws + WS_WD; } }
        float wv[32]; tr_load(t, r, F.lane, wv);
        norm_rows(3);
        tr_store<false>(t, r, F.lane, wv, scr, 1.0f);
    }
#pragma unroll 1
    for (int it = F.gw; it < 2 * JWC; it += F.NGW) {
        int r = it;
        {
            const int l = r / JWC; r %= JWC; const int g = r >> 8, cch = (r >> 4) & 15, nb = r & 15; const int n = nb * 64 + F.lane, c0 = cch * 8;
            const float* Wg = a->in[I_PGW] + ((size_t)(l * 4 + g) * 128 + c0) * 128; const float* sc = a->in[I_PSC] + l * 512 + g * 128; const float* Wpu = a->in[I_WPU] + ((size_t)l * 512 + g * 128) * D + n;
            float acc[8];
#pragma unroll
            for (int j = 0; j < 8; ++j) acc[j] = 0.f;
#pragma unroll 16
            for (int d = 0; d < 128; ++d) { const float w = Wpu[(size_t)d * D] * sc[d];
#pragma unroll
                for (int j = 0; j < 8; ++j) acc[j] += Wg[j * 128 + d] * w; }
            u32x4 o; o.x = cvtpk(acc[0], acc[1]); o.y = cvtpk(acc[2], acc[3]); o.z = cvtpk(acc[4], acc[5]); o.w = cvtpk(acc[6], acc[7]);
            *(u32x4*)((bf16*)(F.ws + WS_WC + l * WC_L) + (size_t)n * 512 + g * 128 + c0) = o;
        }
    }
    norm_rows(M);
    for (int t = F.gw; t < NMETA; t += F.NGW) {
        norm_row(a->in[I_META] + (size_t)t * D, a->in[I_NMIX], (bf16*)(F.ws + SM_MHN) + (size_t)t * D, F.lane);
        float* MH = (float*)(F.ws + SM_MH) + (size_t)t * D; const f32x4* xr = (const f32x4*)(a->in[I_META] + (size_t)t * D) + F.lane;
#pragma unroll
        for (int j = 0; j < 4; ++j) ((f32x4*)MH)[F.lane + 64 * j] = xr[64 * j];
    }
    zero_meta_tiles(F);
}

__device__ __forceinline__ void ph_norm(const Frame& F0, int which) {
    const Frame F = relaunder(F0); KArgs a = kargs();
    const bf16* src = (const bf16*)(F.ws + WS_H); const float* gain = which ? a->in[I_NMIX] + D : a->in[I_NFFN];
    bf16* HN = (bf16*)(F.ws + WS_HN);
    {   f32x4 g[4];
#pragma unroll
        for (int j = 0; j < 4; ++j) g[j] = *(const f32x4*)(gain + rowcol(F.lane, j));
        const bf16* s0 = src + 8 * F.lane; u32x4 ca = *(const u32x4*)(s0 + (size_t)F.gw * D), cb = *(const u32x4*)(s0 + (size_t)F.gw * D + 512);
#pragma unroll 1
        for (int m = F.gw; m < M; m += F.NGW) { const int nm = (m + F.NGW < M) ? m + F.NGW : m;
            const u32x4 na = *(const u32x4*)(s0 + (size_t)nm * D), nb = *(const u32x4*)(s0 + (size_t)nm * D + 512);
            f32x4 v[4]; unpack8(ca, v[0], v[1]); unpack8(cb, v[2], v[3]);
            const float rs = row_rs(v); bf16* dst = HN + (size_t)m * D;
            *(u32x4*)(dst + 8 * F.lane) = pack8(v[0] * rs * g[0], v[1] * rs * g[1]); *(u32x4*)(dst + 512 + 8 * F.lane) = pack8(v[2] * rs * g[2], v[3] * rs * g[3]);
            ca = na; cb = nb; }
    }
    for (int t = F.gw; t < NMETA; t += F.NGW) norm_row((const float*)(F.ws + SM_MH) + (size_t)t * D, gain, (bf16*)(F.ws + SM_MHN) + (size_t)t * D, F.lane);
    if (which) zero_meta_tiles(F);
}

__device__ __forceinline__ void ph_inproj(const Frame& F0, int l) {
    const Frame F = relaunder(F0);
    const bf16* HN = (const bf16*)(F.ws + WS_HN); const bf16* WIN = (const bf16*)(F.ws + WS_WIN + l * WIN_L); const bf16* WV = (const bf16*)(F.ws + WS_WV + l * WV_L);
    {
        EpiInProjMeta Em{(float*)(F.ws + SM_MPROJ), (bf16*)(F.ws + WS_K), (bf16*)(F.ws + WS_U)};
        g16_meta<0>(F, (const bf16*)(F.ws + SM_MHN), D, WIN, D, D, NIN / 32, Em);
        EpiVMeta Ev{(float*)(F.ws + SM_MPROJ), (bf16*)(F.ws + WS_VT)};
        if (F.blk >= 128) { Frame F2 = F; F2.blk = F.blk - 128; F2.G = 128; g16_meta<2>(F2, (const bf16*)(F.ws + SM_MHN), D, WV, D, D, 512 / 32, Ev); }
    }
    EpiInProj E{(bf16*)(F.ws + WS_U), (bf16*)(F.ws + WS_Q), (bf16*)(F.ws + WS_K), (bf16*)(F.ws + WS_G0), (bf16*)(F.ws + WS_G1)};
    EpiV EV{(bf16*)(F.ws + WS_VT)};
#if USE_PG8
    { pg8::StaticOrder So; So.init(M / 256, NIN / 256, F.G, F.blk); pg_gemm<0>(F, HN, WIN, D, So, E); }
    { pg8::StaticOrder So; So.init(M / 256, 512 / 256, F.G, F.blk); pg_gemm<2>(F, HN, WV, D, So, EV); }
#else
    g16_phase<0>(F, HN, D, WIN, D, D, M / 16, NIN / 32, E);
    g16_phase<2>(F, HN, D, WV, D, D, M / 16, 512 / 32, EV);
#endif
}

__device__ __forceinline__ void build_bias(const Frame& F, const float* relb, LAS float* tab) {
    if (F.tid < 512) { const int h = F.tid >> 7, n = F.tid & 127; tab[F.tid] = (relb[t5_bucket(n) * NH + h] - relb[31 * NH + h]) * LOG2E; }
}
__device__ __forceinline__ float layer_lambda(KArgs a, int l, int lane) {
    const float p1 = wave_sum(a->in[I_LQ1][l * 64 + lane] * a->in[I_LK1][l * 64 + lane]);
    const float p2 = wave_sum(a->in[I_LQ2][l * 64 + lane] * a->in[I_LK2][l * 64 + lane]);
    return expf(p1) - expf(p2) + lambda_init(l);
}

__device__ __forceinline__ void meta_mixers(const Frame& F, KArgs a, int l, float lam, const LAS float* biasp) {
    const float* MP = (const float*)(F.ws + SM_MPROJ);
    bf16* MMIX = (bf16*)(F.ws + SM_MMIX); bf16* MBOUT = (bf16*)(F.ws + SM_MBOUT);
    LAS float* QKV = (LAS float*)(F.lds + 4096);
    LAS float* Sc = (LAS float*)(F.lds + 4096 + 98304);
    LAS float* red = (LAS float*)(F.lds + 4096 + 98304 + 8192);
    { f32x4 v[12];
#pragma unroll
      for (int i = 0; i < 12; ++i) { const int idx = F.tid + NTHR * i; const int t = idx / 384, c4 = idx % 384; v[i] = *(const f32x4*)(MP + (size_t)t * 4096 + 512 + 4 * c4); }
#pragma unroll
      for (int i = 0; i < 12; ++i) { const int idx = F.tid + NTHR * i; ((LAS f32x4*)QKV)[idx] = v[i]; } }
#pragma unroll 1
    for (int idx = F.tid; idx < NMETA * 512; idx += NTHR) { const int t = idx >> 9, ch = idx & 511; const int w = 2 << (ch >> 7); const int cnt = (t + 1 < w) ? t + 1 : w;
        float uv[16];
#pragma unroll
        for (int j = 0; j < 16; ++j) uv[j] = (j < cnt) ? MP[(size_t)(t - j) * 4096 + ch] : 0.f;
        float s = 0.f;
#pragma unroll
        for (int j = 0; j < 16; ++j) s += uv[j];
        MMIX[idx] = f2bf(s / (float)cnt - uv[0]); }
    __syncthreads();
#pragma unroll 1
    for (int i = 0; i < 4; ++i) { const int idx = F.tid + NTHR * i; const int t2 = idx & 15, t = (idx >> 4) & 15, c = (idx >> 8) & 1, h = idx >> 9;
        float s = -INFINITY;
        if (t2 <= t) { const LAS f32x4* q = (const LAS f32x4*)(QKV + t * 1536 + h * 128 + c * 64); const LAS f32x4* k = (const LAS f32x4*)(QKV + t2 * 1536 + 512 + h * 128 + c * 64); float d = 0.f;
#pragma unroll
            for (int e = 0; e < 16; ++e) { const f32x4 x = q[e], y = k[e]; d += (x[0] * y[0] + x[1] * y[1]) + (x[2] * y[2] + x[3] * y[3]); }
            s = d * C2 + biasp[h * 128 + (t - t2)]; }
        Sc[idx] = s; }
    __syncthreads();
    if (F.tid < 128) { LAS float* r = Sc + F.tid * 16; float m = -INFINITY; for (int j = 0; j < 16; ++j) m = fmaxf(m, r[j]); float sum = 0.f; float p[16];
#pragma unroll
        for (int j = 0; j < 16; ++j) { p[j] = __builtin_amdgcn_exp2f(r[j] - m); sum += p[j]; }
        const float inv = 1.0f / sum;
#pragma unroll
        for (int j = 0; j < 16; ++j) r[j] = p[j] * inv; }
    __syncthreads();
    { const int h = F.tid >> 7, d = F.tid & 127; float o[16];
        const LAS float* vcol = QKV + 1024 + h * 128 + d;
#pragma unroll
        for (int t = 0; t < 16; ++t) { float acc = 0.f;
#pragma unroll
            for (int t2 = 0; t2 <= t; ++t2) acc += (Sc[((h * 2 + 0) * 16 + t) * 16 + t2] - lam * Sc[((h * 2 + 1) * 16 + t) * 16 + t2]) * vcol[t2 * 1536];
            o[t] = acc; const float ss = wave_sum(acc * acc); if (F.lane == 0) red[F.wave * 16 + t] = ss; }
        __syncthreads();
        const float gn = a->in[I_SUBLN][l * 128 + d] * (1.0f - lambda_init(l));
#pragma unroll
        for (int t = 0; t < 16; ++t) { const float ss = red[(2 * h) * 16 + t] + red[(2 * h + 1) * 16 + t];
            MBOUT[t * 512 + h * 128 + d] = f2bf(o[t] * (1.0f / sqrtf(ss * (1.0f / 128.0f) + SUBLN_EPS)) * gn); }
    }
    __syncthreads();
}

__device__ __forceinline__ void pool_main(const Frame& F) {
    const bf16* U = (const bf16*)(F.ws + WS_U); bf16* AMIX = (bf16*)(F.ws + WS_AMIX);
    const int ch = F.lane * 8, g = ch >> 7, w = 2 << g;
    const float inv = 1.0f / (float)w;
    for (int it = F.gw; it < M / 16; it += F.NGW) { const int r0 = it * 16, s0 = r0 & (S - 1), b = r0 >> 13;
        const bf16* up = U + ((size_t)b * UROWS + NMETA + s0 - 15) * 512 + ch;
        u32x4 raw[31];
#pragma unroll
        for (int i = 0; i < 31; ++i) raw[i] = *(const u32x4*)(up + (size_t)i * 512);
        const u32x4 z4 = (u32x4){0u, 0u, 0u, 0u};
        f32x4 sa = (f32x4){0.f, 0.f, 0.f, 0.f}, sb = sa;
#pragma unroll
        for (int j = 0; j < 16; ++j) { f32x4 a_, b_; unpack8((j < 2 || j < w) ? raw[15 - j] : z4, a_, b_); sa += a_; sb += b_; }
        bf16* dst = AMIX + (size_t)r0 * 512 + ch;
#pragma unroll
        for (int k = 0; k < 16; ++k) {
            f32x4 ua, ub; unpack8(raw[15 + k], ua, ub);
            if (k > 0) { const u32x4 old = (g == 0) ? raw[13 + k] : (g == 1) ? raw[11 + k] : (g == 2) ? raw[7 + k] : raw[k - 1];
                f32x4 oa, ob; unpack8(old, oa, ob); sa += ua - oa; sb += ub - ob; }
            *(u32x4*)(dst + (size_t)k * 512) = pack8(sa * inv - ua, sb * inv - ub);
        }
    }
}

__device__ __forceinline__ void attn_simple(const Frame& F, KArgs a, int l, float lam, const LAS float* biasp) {
    const bf16* Q = (const bf16*)(F.ws + WS_Q); const bf16* Kb = (const bf16*)(F.ws + WS_K); const bf16* VT = (const bf16*)(F.ws + WS_VT); bf16* ABOUT = (bf16*)(F.ws + WS_ABOUT);
    LAS float* Kl = (LAS float*)(F.lds + 16384);
    LAS float* Vl = (LAS float*)(F.lds + 16384 + 16384);
    const int qi = F.tid >> 2, dq = F.tid & 3;
    for (int item = F.blk; item < NB * NH * 64; item += F.G) {
        const int qb = 63 - (item >> 4), bh = item & 15, b = bh >> 2, h = bh & 3;
        const int s = qb * 128 + qi;
        LAS float* o1 = (LAS float*)(F.lds + 65536) + qi * 128 + dq * 32;
#pragma unroll 1
        for (int c = 0; c < 2; ++c) {
            float q[64];
            { const bf16* qp = Q + ((size_t)((bh * 2 + c)) * S + s) * 64;
#pragma unroll
                for (int e = 0; e < 8; ++e) { f32x4 x, y; unpack8(*(const u32x4*)(qp + 8 * e), x, y); q[8 * e + 0] = x[0]; q[8 * e + 1] = x[1]; q[8 * e + 2] = x[2]; q[8 * e + 3] = x[3]; q[8 * e + 4] = y[0]; q[8 * e + 5] = y[1]; q[8 * e + 6] = y[2]; q[8 * e + 7] = y[3]; } }
            float m = -1e30f, lsum = 0.f; float o[32];
#pragma unroll
            for (int e = 0; e < 32; ++e) o[e] = 0.f;
            const int ntiles = 1 + 2 * (qb + 1);
#pragma unroll 1
            for (int jt = 0; jt < ntiles; ++jt) {
                __syncthreads();
                {
                    const int key = F.tid >> 3, ck = F.tid & 7; f32x4 x, y; unpack8(*(const u32x4*)(Kb + ((size_t)(bh * 2 + c) * KROWS + 64 * jt + key) * 64 + 8 * ck), x, y);
                    *(LAS f32x4*)(Kl + key * 64 + 8 * ck) = x; *(LAS f32x4*)(Kl + key * 64 + 8 * ck + 4) = y;
#pragma unroll
                    for (int i2 = 0; i2 < 2; ++i2) { const int idx = F.tid + NTHR * i2; const int d = idx >> 3, cv = idx & 7; f32x4 vx, vy; unpack8(*(const u32x4*)(VT + ((size_t)(bh * 128 + d)) * KROWS + 64 * jt + 8 * cv), vx, vy);
                        float vv[8] = {vx[0], vx[1], vx[2], vx[3], vy[0], vy[1], vy[2], vy[3]};
#pragma unroll
                        for (int e = 0; e < 8; ++e) { const int p = 8 * cv + e; const int sg = (p >> 2) & 3; const int g4 = (sg == 1) ? 2 : (sg == 2) ? 1 : sg; const int key2 = (p & ~15) + 4 * g4 + (p & 3); Vl[key2 * 128 + d] = vv[e]; } }
                }
                __syncthreads();
                const int nk = (jt == 0) ? 16 : 64;
#pragma unroll 1
                for (int j = 0; j < nk; ++j) {
                    int n;
                    if (jt == 0) n = s + 16 - j; else { const int sk = 64 * (jt - 1) + j; n = s - sk; }
                    if (n < 0) continue;
                    float d0 = 0.f, d1 = 0.f; const LAS float* kr = Kl + j * 64;
#pragma unroll
                    for (int e = 0; e < 64; e += 8) { const f32x4 k0 = *(const LAS f32x4*)(kr + e), k1 = *(const LAS f32x4*)(kr + e + 4);
                        d0 += q[e] * k0[0] + q[e + 1] * k0[1] + q[e + 2] * k0[2] + q[e + 3] * k0[3]; d1 += q[e + 4] * k1[0] + q[e + 5] * k1[1] + q[e + 6] * k1[2] + q[e + 7] * k1[3]; }
                    const float sc = d0 + d1 + biasp[h * 128 + (n < 127 ? n : 127)];
                    if (sc > m) { const float corr = __builtin_amdgcn_exp2f(m - sc); lsum *= corr;
#pragma unroll
                        for (int e = 0; e < 32; ++e) o[e] *= corr;
                        m = sc; }
                    const float p = __builtin_amdgcn_exp2f(sc - m); lsum += p;
                    const LAS float* vr = Vl + j * 128 + dq * 32;
#pragma unroll
                    for (int e = 0; e < 32; e += 4) { const f32x4 v4 = *(const LAS f32x4*)(vr + e); o[e] += p * v4[0]; o[e + 1] += p * v4[1]; o[e + 2] += p * v4[2]; o[e + 3] += p * v4[3]; }
                }
            }
            const float inv = 1.0f / lsum;
            if (c == 0) {
#pragma unroll
                for (int e = 0; e < 32; ++e) o1[e] = o[e] * inv; }
            else {
                float ss = 0.f;
#pragma unroll
                for (int e = 0; e < 32; ++e) { o[e] = o1[e] - lam * (o[e] * inv); ss += o[e] * o[e]; }
                ss = xor1_add(ss); ss = xor2_add(ss);
                const float rs = 1.0f / sqrtf(ss * (1.0f / 128.0f) + SUBLN_EPS) * (1.0f - lambda_init(l));
                const float* gn = a->in[I_SUBLN] + l * 128 + dq * 32; bf16* dst = ABOUT + (size_t)(b * S + s) * 512 + h * 128 + dq * 32;
#pragma unroll
                for (int e = 0; e < 32; e += 8) { f32x4 x = (f32x4){o[e] * rs * gn[e], o[e + 1] * rs * gn[e + 1], o[e + 2] * rs * gn[e + 2], o[e + 3] * rs * gn[e + 3]};
                    f32x4 y = (f32x4){o[e + 4] * rs * gn[e + 4], o[e + 5] * rs * gn[e + 5], o[e + 6] * rs * gn[e + 6], o[e + 7] * rs * gn[e + 7]}; *(u32x4*)(dst + e) = pack8(x, y); }
            }
        }
    }
}


typedef float f32x16 __attribute__((ext_vector_type(16)));
__device__ __forceinline__ void glds_r(const void* sbase, unsigned voff, unsigned ldsaddr) {
    asm volatile("s_mov_b32 m0, %2\n\ts_nop 0\n\tglobal_load_lds_dwordx4 %0, %1" :: "v"(voff), "s"(sbase), "s"(ldsaddr) : "memory", "m0"); }
__device__ __forceinline__ int crow(int r, int hi) { return (r & 3) + 8 * (r >> 2) + 4 * hi; }
constexpr int AT_KT = 8 * 1040, AT_VT = 8 * 2064;
constexpr float AT_THR = 8.0f;
__device__ __forceinline__ float xor16_add(float v) { return v + __builtin_bit_cast(float, __builtin_amdgcn_ds_swizzle(__builtin_bit_cast(int, v), 0x401F)); }
__device__ __forceinline__ float half_max(float m) { auto rr = __builtin_amdgcn_permlane32_swap(__builtin_bit_cast(unsigned, m), __builtin_bit_cast(unsigned, m), false, false); return fmaxf(__builtin_bit_cast(float, rr[0]), __builtin_bit_cast(float, rr[1])); }
#define AT_SBAR() __builtin_amdgcn_sched_barrier(0)
#define AT_PIN(x) asm volatile("" : "+v"(x))
#define AT_MFMA(a, b, c) __builtin_amdgcn_mfma_f32_32x32x16_bf16(a, b, c, 0, 0, 0)
constexpr int AT_VTN = 516;
struct AtC {
    const bf16* kgs; const bf16* vgs; unsigned kvo, vvo0, vvo1, ldsK, ldsV;
    const LAS unsigned char* tilesK; const LAS unsigned char* tilesV; unsigned kfo, vfo;
    const LAS float* vt4; LAS float* wsf; int s0w, r32, hi; };
template <int WN> __device__ __forceinline__ void at_waitbar() {
    if constexpr (WN == 4) asm volatile("s_waitcnt vmcnt(4) lgkmcnt(0)\n\ts_barrier" ::: "memory");
    else if constexpr (WN == 3) asm volatile("s_waitcnt vmcnt(3) lgkmcnt(0)\n\ts_barrier" ::: "memory");
    else if constexpr (WN == 2) asm volatile("s_waitcnt vmcnt(2) lgkmcnt(0)\n\ts_barrier" ::: "memory");
    else if constexpr (WN == 0) asm volatile("s_waitcnt vmcnt(0) lgkmcnt(0)\n\ts_barrier" ::: "memory");
}
template <bool META> __device__ __forceinline__ void at_bias(const AtC& X, int kbase, f32x16& p0, f32x16& p1) {
    int nbc = X.s0w + X.r32 - kbase; nbc = nbc > 200 ? 200 : nbc;
    int a0 = 255 - nbc + 4 * X.hi; asm volatile("" : "+v"(a0));
    const LAS float* tp = X.vt4 + (a0 & 3) * AT_VTN + (a0 & ~3);
    { f32x4 bq[4];
#pragma unroll
      for (int g = 0; g < 4; ++g) bq[g] = *(const LAS f32x4*)(tp + 8 * g);
#pragma unroll
      for (int g = 0; g < 4; ++g)
#pragma unroll
          for (int j = 0; j < 4; ++j) { if constexpr (META) p0[4 * g + j] += (g < 2) ? bq[g][j] : -INFINITY; else p0[4 * g + j] += bq[g][j]; } }
    { f32x4 bq[4];
#pragma unroll
      for (int g = 0; g < 4; ++g) bq[g] = *(const LAS f32x4*)(tp + 32 + 8 * g);
#pragma unroll
      for (int g = 0; g < 4; ++g)
#pragma unroll
          for (int j = 0; j < 4; ++j) { if constexpr (META) p1[4 * g + j] = -INFINITY; else p1[4 * g + j] += bq[g][j]; } }
}
__device__ __forceinline__ float at_rowmax(const f32x16& p0, const f32x16& p1) {
    float rm = fmaxf(fmaxf(p0[0], p0[1]), p1[0]);
#pragma unroll
    for (int r = 2; r < 16; r += 2) rm = fmaxf(fmaxf(rm, p0[r]), p0[r + 1]);
#pragma unroll
    for (int r = 1; r < 15; r += 2) rm = fmaxf(fmaxf(rm, p1[r]), p1[r + 1]);
    rm = fmaxf(rm, p1[15]);
    return half_max(rm);
}
template <bool GK, bool GV, bool GL, int WN>
__device__ __forceinline__ void at_step(const AtC& X, const int t, int& ks_cur, int& vs_prev, f32x16& C0, f32x16& C1, f32x16& P0, f32x16& P1,
                                        bf16x8 (&kf)[8], const bf16x8 (&qr)[4], f32x16 (&o)[4], float& mhat, float& lsum) {
    AT_SBAR();
    const f32x16 zero16 = {0.f, 0.f, 0.f, 0.f, 0.f, 0.f, 0.f, 0.f, 0.f, 0.f, 0.f, 0.f, 0.f, 0.f, 0.f, 0.f};
    const LAS unsigned char* vp = X.tilesV + vs_prev * AT_VT + X.vfo;
    const int ks_next = (ks_cur == 2) ? 0 : ks_cur + 1;
    const LAS unsigned char* ktn = X.tilesK + ks_next * AT_KT + X.kfo;
    bf16x8 vf[8]; u32x4 pw0, pw1, pw2, pw3;
    const unsigned lv_ = (unsigned)__builtin_amdgcn_readfirstlane((int)(X.ldsV + (unsigned)((vs_prev + 3) & 3) * AT_VT));
    f32x2 sacc2 = (f32x2){P0[0], P0[1]};
#define AT_VRD(m) vf[(m) & 7] = *(const LAS bf16x8*)(vp + ((m) >> 2) * 4128 + ((m) & 3) * 512)
#define AT_GAPA(m, MF, a0, a1, a2, a3, W0, W1, PW) do { AT_VRD(m); AT_SBAR(); MF; sacc2 += (f32x2){a0, a1}; sacc2 += (f32x2){a2, a3}; W0; W1; AT_PIN(PW); AT_PIN(sacc2); AT_SBAR(); } while (0)
    AT_GAPA(0, C0 = AT_MFMA(kf[0], qr[0], zero16), P0[2], P0[3], P0[4], P0[5],     pw0[0] = cvtpk(P0[0], P0[1]),   pw0[1] = cvtpk(P0[2], P0[3]),   pw0);
    AT_GAPA(1, C1 = AT_MFMA(kf[1], qr[0], zero16), P0[6], P0[7], P0[8], P0[9],     pw0[2] = cvtpk(P0[4], P0[5]),   pw0[3] = cvtpk(P0[6], P0[7]),   pw0);
    if constexpr (GK) { glds_r(X.kgs + (size_t)(t + 3) * 4096, X.kvo, (unsigned)__builtin_amdgcn_readfirstlane((int)(X.ldsK + (unsigned)ks_cur * AT_KT))); AT_SBAR(); }
    AT_GAPA(2, C0 = AT_MFMA(kf[2], qr[1], C0),   P0[10], P0[11], P0[12], P0[13], pw1[0] = cvtpk(P0[8], P0[9]),   pw1[1] = cvtpk(P0[10], P0[11]), pw1);
    AT_GAPA(3, C1 = AT_MFMA(kf[3], qr[1], C1),   P0[14], P0[15], P1[0], P1[1],   pw1[2] = cvtpk(P0[12], P0[13]), pw1[3] = cvtpk(P0[14], P0[15]), pw1);
    if constexpr (GV) { glds_r(X.vgs + (t + 2) * 64, X.vvo0, lv_); AT_SBAR(); }
    AT_GAPA(4, C0 = AT_MFMA(kf[4], qr[2], C0),   P1[2], P1[3], P1[4], P1[5],     pw2[0] = cvtpk(P1[0], P1[1]),   pw2[1] = cvtpk(P1[2], P1[3]),   pw2);
    AT_GAPA(5, C1 = AT_MFMA(kf[5], qr[2], C1),   P1[6], P1[7], P1[8], P1[9],     pw2[2] = cvtpk(P1[4], P1[5]),   pw2[3] = cvtpk(P1[6], P1[7]),   pw2);
    if constexpr (GV) { glds_r(X.vgs + (t + 2) * 64, X.vvo1, lv_ + 1024u); AT_SBAR(); }
    AT_GAPA(6, C0 = AT_MFMA(kf[6], qr[3], C0),   P1[10], P1[11], P1[12], P1[13], pw3[0] = cvtpk(P1[8], P1[9]),   pw3[1] = cvtpk(P1[10], P1[11]), pw3);
    AT_GAPA(7, C1 = AT_MFMA(kf[7], qr[3], C1),   P1[14], P1[15], 0.f, 0.f,       pw3[2] = cvtpk(P1[12], P1[13]), pw3[3] = cvtpk(P1[14], P1[15]), pw3);
    lsum += sacc2[0] + sacc2[1];
    const int kbase = 64 * (t - 1);
    if (X.s0w - (kbase + 63) < 113) at_bias<false>(X, kbase, C0, C1);
    const float rm = at_rowmax(C0, C1) - mhat;
    bool resc = false;
    if (__any(rm > AT_THR)) {
        const float dl = fmaxf(rm, 0.f); mhat += dl;
        const float f = __builtin_amdgcn_exp2f(-dl); lsum *= f;
        if (X.hi == 0) X.wsf[X.r32] = f;
        resc = true;
    }
    const f32x2 mh2 = (f32x2){mhat, mhat};
    AT_SBAR();
#define AT_PAF(k) __builtin_bit_cast(bf16x8, pw##k)
#define AT_GAPB(m, PK, CX, e) do { o[(m) & 3] = AT_MFMA(AT_PAF(PK), vf[(m) & 7], o[(m) & 3]); \
        if ((m) < 8) AT_VRD((m) + 8); \
        if (GL && (m) >= 4 && (m) < 12) kf[((m) - 4) & 7] = *(const LAS bf16x8*)(ktn + ((((m) - 4) & 7) >> 1) * 2080 + (((m) - 4) & 1) * 512); \
        { const f32x2 x_ = (f32x2){CX[e], CX[(e) + 1]} - mh2; CX[e] = __builtin_amdgcn_exp2f(x_[0]); CX[(e) + 1] = __builtin_amdgcn_exp2f(x_[1]); } AT_PIN(CX); AT_SBAR(); } while (0)
    AT_GAPB(0, 0, C0, 0);  AT_GAPB(1, 0, C0, 2);   AT_GAPB(2, 0, C0, 4);   AT_GAPB(3, 0, C0, 6);
    AT_GAPB(4, 1, C0, 8);  AT_GAPB(5, 1, C0, 10);  AT_GAPB(6, 1, C0, 12);  AT_GAPB(7, 1, C0, 14);
    AT_GAPB(8, 2, C1, 0);  AT_GAPB(9, 2, C1, 2);   AT_GAPB(10, 2, C1, 4);  AT_GAPB(11, 2, C1, 6);
    AT_GAPB(12, 3, C1, 8); AT_GAPB(13, 3, C1, 10); AT_GAPB(14, 3, C1, 12); AT_GAPB(15, 3, C1, 14);
    at_waitbar<WN>();
    if (resc) {
#pragma unroll
        for (int r = 0; r < 16; ++r) { const float fr_ = X.wsf[crow(r, X.hi)];
#pragma unroll
            for (int i = 0; i < 4; ++i) o[i][r] *= fr_; }
    }
    vs_prev = (vs_prev + 1) & 3; ks_cur = ks_next;
#undef AT_VRD
#undef AT_GAPA
#undef AT_GAPB
#undef AT_PAF
}

__device__ __forceinline__ void attn_mfma(const Frame& F, KArgs a, int l, float lam, const LAS float* biasp) {
    const bf16* Q = (const bf16*)(F.ws + WS_Q); const bf16* Kb = (const bf16*)(F.ws + WS_K); const bf16* VT = (const bf16*)(F.ws + WS_VT); bf16* ABOUT = (bf16*)(F.ws + WS_ABOUT);
    const int lane = F.lane, r32 = lane & 31, hi = lane >> 5, wid = F.wave;
    float* O1S = (float*)(F.ws + WS_O1S) + (size_t)F.blk * 32768 + (size_t)wid * 4096;
    LAS float* wsf = (LAS float*)(F.lds + 2048) + wid * 32;
    LAS unsigned char* tilesK = F.lds + 4096;
    LAS unsigned char* tilesV = F.lds + 4096 + 3 * AT_KT;
    const int vcu = (F.blk & 7) * (F.G >> 3) + (F.blk >> 3);
    const int bh = vcu >> 4, sidx = vcu & 15, b = bh >> 2, h = bh & 3;
    const LAS float* bh_bias = biasp + h * 128;
    constexpr int VTN = AT_VTN;
    LAS float* vt4 = (LAS float*)(F.lds + 98304);
    for (int idx = F.tid; idx < 4 * VTN; idx += NTHR) { const int k = idx / VTN, i = idx % VTN, n = 255 - (i + k); vt4[idx] = (n < 0) ? -INFINITY : (n <= 127 ? bh_bias[n] : 0.f); }
    __syncthreads();
    AtC X;
    X.kvo = (unsigned)(lane * 64 + 8 * wid) * 2u;
    X.vvo0 = (unsigned)(lane * KROWS + 8 * wid) * 2u; X.vvo1 = (unsigned)((64 + lane) * KROWS + 8 * wid) * 2u;
    X.ldsK = (unsigned)(__UINTPTR_TYPE__)tilesK + (unsigned)wid * 1040u; X.ldsV = (unsigned)(__UINTPTR_TYPE__)tilesV + (unsigned)wid * 2064u;
    X.kfo = hi * 1040 + r32 * 16;
    X.vfo = hi * 2064 + r32 * 16;
    X.tilesK = tilesK; X.tilesV = tilesV; X.vt4 = vt4; X.wsf = wsf; X.r32 = r32; X.hi = hi;
#pragma unroll 1
    for (int ui = 0; ui < 2; ++ui) {
        const int qb = (ui == 0) ? 31 - sidx : sidx;
        const int s0w = qb * 256 + wid * 32;
        const int NT = 1 + 4 * (qb + 1);
        X.s0w = s0w;
#pragma unroll 1
        for (int c = 0; c < 2; ++c) {
            X.kgs = Kb + (size_t)(bh * 2 + c) * KROWS * 64;
            X.vgs = VT + (size_t)bh * 128 * KROWS;
#define AT_STAGE_K(t, ks_) glds_r(X.kgs + (size_t)(t) * 4096, X.kvo, (unsigned)__builtin_amdgcn_readfirstlane((int)(X.ldsK + (unsigned)(ks_) * AT_KT)))
#define AT_STAGE_V(t, vs_) do { const unsigned lv_ = (unsigned)__builtin_amdgcn_readfirstlane((int)(X.ldsV + (unsigned)(vs_) * AT_VT)); glds_r(X.vgs + (t) * 64, X.vvo0, lv_); glds_r(X.vgs + (t) * 64, X.vvo1, lv_ + 1024u); } while (0)
            bf16x8 qr[4];
            { int lq = lane; asm volatile("" : "+v"(lq));
              const bf16* qp = Q + ((size_t)(bh * 2 + c) * S + s0w + (lq & 31)) * 64 + (lq >> 5) * 8;
#pragma unroll
              for (int d0 = 0; d0 < 4; ++d0) qr[d0] = *(const bf16x8*)(qp + d0 * 16); }
            f32x16 o[4];
#pragma unroll
            for (int i = 0; i < 4; ++i)
#pragma unroll
                for (int r = 0; r < 16; ++r) o[i][r] = 0.f;
            float mhat = 0.f, lsum = 0.f;
            const f32x16 zero16 = {0.f, 0.f, 0.f, 0.f, 0.f, 0.f, 0.f, 0.f, 0.f, 0.f, 0.f, 0.f, 0.f, 0.f, 0.f, 0.f};
            f32x16 pA0, pA1, pB0, pB1; bf16x8 kf[8];
            __syncthreads();
            AT_STAGE_K(0, 0); AT_STAGE_V(0, 0); AT_STAGE_K(1, 1); AT_STAGE_V(1, 1); AT_STAGE_K(2, 2);
            at_waitbar<4>();
            asm volatile("" : "+v"(qr[0]), "+v"(qr[1]), "+v"(qr[2]), "+v"(qr[3]));
            { const LAS unsigned char* kt = tilesK + X.kfo;
#pragma unroll
              for (int d0 = 0; d0 < 4; ++d0) { kf[2 * d0] = *(const LAS bf16x8*)(kt + d0 * 2080); kf[2 * d0 + 1] = *(const LAS bf16x8*)(kt + d0 * 2080 + 512); } }
            pA0 = AT_MFMA(kf[0], qr[0], zero16); pA1 = AT_MFMA(kf[1], qr[0], zero16); pA0 = AT_MFMA(kf[2], qr[1], pA0); pA1 = AT_MFMA(kf[3], qr[1], pA1);
            pA0 = AT_MFMA(kf[4], qr[2], pA0); pA1 = AT_MFMA(kf[5], qr[2], pA1); pA0 = AT_MFMA(kf[6], qr[3], pA0); pA1 = AT_MFMA(kf[7], qr[3], pA1);
            at_bias<true>(X, -16, pA0, pA1);
            { const float rm = at_rowmax(pA0, pA1); mhat = rm;
#pragma unroll
              for (int r = 0; r < 16; ++r) { pA0[r] = __builtin_amdgcn_exp2f(pA0[r] - rm); pA1[r] = __builtin_amdgcn_exp2f(pA1[r] - rm); } }
            at_waitbar<0>();
            AT_STAGE_K(3, 0); AT_STAGE_V(2, 2);
            { const LAS unsigned char* kt = tilesK + AT_KT + X.kfo;
#pragma unroll
              for (int d0 = 0; d0 < 4; ++d0) { kf[2 * d0] = *(const LAS bf16x8*)(kt + d0 * 2080); kf[2 * d0 + 1] = *(const LAS bf16x8*)(kt + d0 * 2080 + 512); } }
            at_waitbar<3>();
            int ks_cur = 1, vs_prev = 0;
            int t = 1;
#pragma unroll 1
            for (; t + 4 < NT; t += 2) {
                at_step<true, true, true, 3>(X, t, ks_cur, vs_prev, pB0, pB1, pA0, pA1, kf, qr, o, mhat, lsum);
                at_step<true, true, true, 3>(X, t + 1, ks_cur, vs_prev, pA0, pA1, pB0, pB1, kf, qr, o, mhat, lsum);
            }
            at_step<true, true, true, 3>(X, t, ks_cur, vs_prev, pB0, pB1, pA0, pA1, kf, qr, o, mhat, lsum);
            at_step<false, true, true, 2>(X, t + 1, ks_cur, vs_prev, pA0, pA1, pB0, pB1, kf, qr, o, mhat, lsum);
            at_step<false, false, true, 0>(X, t + 2, ks_cur, vs_prev, pB0, pB1, pA0, pA1, kf, qr, o, mhat, lsum);
            at_step<false, false, false, -1>(X, t + 3, ks_cur, vs_prev, pA0, pA1, pB0, pB1, kf, qr, o, mhat, lsum);
            {
                float sacc = 0.f;
#pragma unroll
                for (int r = 0; r < 16; ++r) sacc += pA0[r] + pA1[r];
                lsum += sacc;
                bf16x8 pa[4]; u32x4 w;
                w = (u32x4){cvtpk(pA0[0], pA0[1]), cvtpk(pA0[2], pA0[3]), cvtpk(pA0[4], pA0[5]), cvtpk(pA0[6], pA0[7])}; pa[0] = __builtin_bit_cast(bf16x8, w);
                w = (u32x4){cvtpk(pA0[8], pA0[9]), cvtpk(pA0[10], pA0[11]), cvtpk(pA0[12], pA0[13]), cvtpk(pA0[14], pA0[15])}; pa[1] = __builtin_bit_cast(bf16x8, w);
                w = (u32x4){cvtpk(pA1[0], pA1[1]), cvtpk(pA1[2], pA1[3]), cvtpk(pA1[4], pA1[5]), cvtpk(pA1[6], pA1[7])}; pa[2] = __builtin_bit_cast(bf16x8, w);
                w = (u32x4){cvtpk(pA1[8], pA1[9]), cvtpk(pA1[10], pA1[11]), cvtpk(pA1[12], pA1[13]), cvtpk(pA1[14], pA1[15])}; pa[3] = __builtin_bit_cast(bf16x8, w);
                const LAS unsigned char* vp = tilesV + vs_prev * AT_VT + X.vfo;
#pragma unroll
                for (int ks = 0; ks < 4; ++ks)
#pragma unroll
                    for (int i = 0; i < 4; ++i) { const bf16x8 vf = *(const LAS bf16x8*)(vp + ks * 4128 + i * 512); o[i] = AT_MFMA(pa[ks], vf, o[i]); }
            }
#undef AT_STAGE_K
#undef AT_STAGE_V
            { auto rr = __builtin_amdgcn_permlane32_swap(__builtin_bit_cast(unsigned, lsum), __builtin_bit_cast(unsigned, lsum), false, false); lsum = __builtin_bit_cast(float, rr[0]) + __builtin_bit_cast(float, rr[1]); }
            const int le = lane_id_fresh(), r32e = le & 31, hie = le >> 5;
            if (hie == 0) wsf[r32e] = __builtin_amdgcn_rcpf(lsum);
            LDS_WAIT();
            float* o1p = O1S; bf16* abp = ABOUT; asm volatile("" : "+s"(o1p), "+s"(abp));
            o1p += le * 64;
            float linv[16];
#pragma unroll
            for (int r = 0; r < 16; ++r) linv[r] = wsf[crow(r, hie)];
            if (c == 0) {
#pragma unroll
                for (int i = 0; i < 4; ++i)
#pragma unroll
                    for (int q4 = 0; q4 < 4; ++q4) { const f32x4 v = (f32x4){o[i][4 * q4] * linv[4 * q4], o[i][4 * q4 + 1] * linv[4 * q4 + 1], o[i][4 * q4 + 2] * linv[4 * q4 + 2], o[i][4 * q4 + 3] * linv[4 * q4 + 3]};
                        *(f32x4*)(o1p + (i * 4 + q4) * 4) = v; }
                VM_WAIT();
            } else {
                typedef const __attribute__((address_space(1))) f32x4* gp4_t; typedef const __attribute__((address_space(1))) float* gp1_t;
                const float osc = 1.0f - lambda_init(l); float gn[4];
                { gp1_t sl = (gp1_t)(a->in[I_SUBLN] + l * 128 + r32e);
#pragma unroll
                  for (int i = 0; i < 4; ++i) gn[i] = sl[32 * i]; }
                f32x4 v1[16];
                { gp4_t op = (gp4_t)o1p;
#pragma unroll
                  for (int q = 0; q < 16; ++q) v1[q] = op[q]; }
                __builtin_amdgcn_sched_barrier(0);
#pragma unroll
                for (int i = 0; i < 4; ++i) gn[i] *= osc;
#pragma unroll
                for (int i = 0; i < 4; ++i)
#pragma unroll
                    for (int q4 = 0; q4 < 4; ++q4)
#pragma unroll
                        for (int e = 0; e < 4; ++e) o[i][4 * q4 + e] = v1[i * 4 + q4][e] - lam * (o[i][4 * q4 + e] * linv[4 * q4 + e]);
                const unsigned rowb = (unsigned)(b * S + s0w) * 512u + (unsigned)(h * 128 + r32e);
#pragma unroll
                for (int r = 0; r < 16; ++r) {
                    float ss = (o[0][r] * o[0][r] + o[1][r] * o[1][r]) + (o[2][r] * o[2][r] + o[3][r] * o[3][r]);
                    ss = xor1_add(ss); ss = xor2_add(ss); ss += dpp_f<0x124>(ss); ss += dpp_f<0x128>(ss); ss = xor16_add(ss);
                    const float rs = __builtin_amdgcn_rsqf(ss * (1.0f / 128.0f) + SUBLN_EPS);
                    bf16* dst = abp + (rowb + (unsigned)crow(r, hie) * 512u);
#pragma unroll
                    for (int i = 0; i < 4; ++i) dst[32 * i] = f2bf(o[i][r] * rs * gn[i]);
                }
            }
        }
    }
}

__device__ __forceinline__ void ph_mixers(const Frame& F0, KArgs a, int l) {
    const Frame F = relaunder(F0);
    LAS float* biasp = (LAS float*)(F.lds + 0);
    build_bias(F, a->in[I_RELB], biasp);
    const float lam = layer_lambda(a, l, F.lane);
    __syncthreads();
    if (l == 0 && F.blk == 0) meta_mixers(F, a, l, lam, biasp);
    pool_main(F);
#if USE_MFMA_ATTN
    attn_mfma(F, a, l, lam, biasp);
#else
    attn_simple(F, a, l, lam, biasp);
#endif
}

__device__ __forceinline__ void ph_merge(const Frame& F0, int l) {
    const Frame F = relaunder(F0);
    const bf16* WC = (const bf16*)(F.ws + WS_WC + l * WC_L); const bf16* WAU = (const bf16*)(F.ws + WS_WAU + l * WC_L);
    if (l == 0) {
        EpiPMeta Ep{(const float*)(F.ws + SM_MPROJ), (float*)(F.ws + SM_MTMP)};
        g16_meta<0>(F, (const bf16*)(F.ws + SM_MMIX), 512, WC, 512, 512, D / 32, Ep);
        VM_WAIT();
        EpiQMeta Eq{(const float*)(F.ws + SM_MPROJ), (const float*)(F.ws + SM_MTMP), (bf16*)(F.ws + SM_MMERG)};
        g16_meta<0>(F, (const bf16*)(F.ws + SM_MBOUT), 512, WAU, 512, 512, D / 32, Eq);
    }
    EpiP E1{(const bf16*)(F.ws + WS_G0), (bf16*)(F.ws + WS_TMP)};
    EpiQm E2{(const bf16*)(F.ws + WS_G0), (const bf16*)(F.ws + WS_TMP), (bf16*)(F.ws + WS_MERGED)};
#if USE_PG8
    pg8::StaticOrder So; So.init(M / 256, D / 256, F.G, F.blk);
    pg_gemm<0>(F, (const bf16*)(F.ws + WS_AMIX), WC, 512, So, E1);
    VM_WAIT();
    pg_gemm<0>(F, (const bf16*)(F.ws + WS_ABOUT), WAU, 512, So, E2);
#else
    g16_phase<0>(F, (const bf16*)(F.ws + WS_AMIX), 512, WC, 512, 512, M / 16, D / 32, E1);
    VM_WAIT();
    g16_phase<0>(F, (const bf16*)(F.ws + WS_ABOUT), 512, WAU, 512, 512, M / 16, D / 32, E2);
#endif
}
__device__ __forceinline__ void ph_outproj(const Frame& F0, KArgs a, int l) {
    const Frame F = relaunder(F0);
    const bf16* WOUT = (const bf16*)(F.ws + WS_WOUT + l * WOUT_L);
    if (l == 0) { EpiRes Em{(const float*)(F.ws + SM_MH), (float*)(F.ws + SM_MH)}; g16_meta<0>(F, (const bf16*)(F.ws + SM_MMERG), D, WOUT, D, D, D / 32, Em); }
    pg8::StaticOrder So; So.init(M / 256, D / 256, F.G, F.blk);
    if (l == 0) { EpiResX E{a->in[I_X], (bf16*)(F.ws + WS_H)}; pg_gemm<0>(F, (const bf16*)(F.ws + WS_MERGED), WOUT, D, So, E); }
    else { EpiResH E{(bf16*)(F.ws + WS_H)}; pg_gemm<0>(F, (const bf16*)(F.ws + WS_MERGED), WOUT, D, So, E); }
}
__device__ __forceinline__ void ph_ffn_gu(const Frame& F0) {
    const Frame F = relaunder(F0);
    { EpiGU Em{(bf16*)(F.ws + SM_MACT), 0}; g16_meta<1>(F, (const bf16*)(F.ws + SM_MHN), D, (const bf16*)(F.ws + WS_WGU), D, D, DFF / 32, Em); }
    EpiGU E{(bf16*)(F.ws + WS_ACT), 0};
#if USE_PG8
    pg8::StaticOrder So; So.init(M / 256, DFF / 128, F.G, F.blk); pg_gemm<1>(F, (const bf16*)(F.ws + WS_HN), (const bf16*)(F.ws + WS_WGU), D, So, E);
#else
    g16_phase<1>(F, (const bf16*)(F.ws + WS_HN), D, (const bf16*)(F.ws + WS_WGU), D, D, M / 16, DFF / 32, E);
#endif
}
__device__ __forceinline__ void ph_ffn_down(const Frame& F0) {
    const Frame F = relaunder(F0);
    { EpiRes Em{(const float*)(F.ws + SM_MH), (float*)(F.ws + SM_MH)}; g16_meta<0>(F, (const bf16*)(F.ws + SM_MACT), DFF, (const bf16*)(F.ws + WS_WD), DFF, DFF, D / 32, Em); }
    EpiResH E{(bf16*)(F.ws + WS_H)};
    pg8::StaticOrder So; So.init(M / 256, D / 256, F.G, F.blk); So.rev = true; pg_gemm<0>(F, (const bf16*)(F.ws + WS_ACT), (const bf16*)(F.ws + WS_WD), DFF, So, E);
}

__device__ __forceinline__ void ph_route1(const Frame& F0, KArgs a) {
    const Frame F = relaunder(F0);
    LAS float* scr = (LAS float*)(F.lds + F.wave * 16384);
    LAS int* hist = (LAS int*)(F.lds + 12288);
    if (F.tid < 8) hist[F.tid] = 0;
    __syncthreads();
    constexpr int J6 = 16 * 112, J8 = 56 * 32, JE = 2 * J6 + J8;
    const float* gain = a->in[I_NFFN] + D; const float* router = a->in[I_ROUTER];
    float rg[16][8];
#pragma unroll
    for (int j = 0; j < 4; ++j) { const int k0 = rowcol(F.lane, j); const f32x4 g = *(const f32x4*)(gain + k0);
#pragma unroll
        for (int kk = 0; kk < 4; ++kk) { const f32x4 r0 = *(const f32x4*)(router + (size_t)(k0 + kk) * 8), r1 = *(const f32x4*)(router + (size_t)(k0 + kk) * 8 + 4);
#pragma unroll
            for (int e = 0; e < 4; ++e) { rg[4 * j + kk][e] = g[kk] * r0[e]; rg[4 * j + kk][4 + e] = g[kk] * r1[e]; } } }
    const bf16* hrow = (const bf16*)(F.ws + WS_H) + (size_t)(F.blk * 128 + F.wave * 16) * D + 8 * F.lane;
    u32x4 ca = *(const u32x4*)hrow, cb = *(const u32x4*)(hrow + 512);
    auto router_row = [&](int i) { const int row = F.blk * 128 + F.wave * 16 + i;
        const bf16* nrow = hrow + (size_t)((i + 1 < 16) ? i + 1 : i) * D;
        const u32x4 na = *(const u32x4*)nrow, nb = *(const u32x4*)(nrow + 512);
        f32x4 v[4]; unpack8(ca, v[0], v[1]); unpack8(cb, v[2], v[3]);
        const float rs = row_rs(v);
        float lg[8];
#pragma unroll
        for (int e = 0; e < 8; ++e) lg[e] = 0.f;
#pragma unroll
        for (int j = 0; j < 4; ++j)
#pragma unroll
            for (int kk = 0; kk < 4; ++kk)
#pragma unroll
                for (int e = 0; e < 8; ++e) lg[e] += v[j][kk] * rg[4 * j + kk][e];
#pragma unroll
        for (int e = 0; e < 8; ++e) lg[e] = wave_sum(lg[e]) * rs;
        ca = na; cb = nb;
        int e0 = 0; float v0 = lg[0];
#pragma unroll
        for (int e = 1; e < 8; ++e) if (lg[e] > v0) { v0 = lg[e]; e0 = e; }
        int e1 = -1; float v1 = -INFINITY;
#pragma unroll
        for (int e = 0; e < 8; ++e) if (e != e0 && lg[e] > v1) { v1 = lg[e]; e1 = e; }
        const float p1 = __builtin_amdgcn_exp2f((v1 - v0) * LOG2E); const float w0 = 1.0f / (1.0f + p1), w1 = p1 / (1.0f + p1);
        if (F.lane == 0) { ((float*)(F.ws + SM_RS))[row] = rs; ((int*)(F.ws + SM_EW))[row] = e0 | (e1 << 8); ((float*)(F.ws + SM_W0))[row] = w0; ((float*)(F.ws + SM_W1))[row] = w1;
            atomicAdd((int*)&hist[e0], 1); atomicAdd((int*)&hist[e1], 1); }
    };
    int ri = 0;
#pragma unroll 1
    for (int it = F.gw; it < NE * JE; it += F.NGW) { const int e = it / JE; int r = it % JE; TrSrc t; t.col0 = 0;
        if (r < J6) { t.W = a->in[I_MG] + (size_t)e * D * DFF; t.ldw = DFF; t.K = D; t.ncols = DFF; t.WT = F.ws + WS_WGUE + e * WGUE_L; t.row0 = 0; t.gu = 1; }
        else if (r < 2 * J6) { r -= J6; t.W = a->in[I_MU] + (size_t)e * D * DFF; t.ldw = DFF; t.K = D; t.ncols = DFF; t.WT = F.ws + WS_WGUE + e * WGUE_L; t.row0 = 128; t.gu = 1; }
        else { r -= 2 * J6; t.W = a->in[I_MD] + (size_t)e * DFF * D; t.ldw = D; t.K = DFF; t.ncols = D; t.WT = F.ws + WS_WDE + e * WDE_L; t.row0 = 0; t.gu = 0; }
        float wv[32]; tr_load(t, r, F.lane, wv);
        if (ri < 16) { router_row(ri); ++ri; }
        tr_store<true>(t, r, F.lane, wv, scr, SC_W8); }
#pragma unroll 1
    for (; ri < 16; ++ri) router_row(ri);
    __syncthreads();
    if (F.tid < 8) ((int*)(F.ws + SM_HIST))[F.blk * 8 + F.tid] = hist[F.tid];
}
__device__ __forceinline__ void ph_route2(const Frame& F0, KArgs a) {
    const Frame F = relaunder(F0);
    LAS int* tot = (LAS int*)(F.lds + 0);
    LAS int* rslot = (LAS int*)(F.lds + 1024);
    const int* HIST = (const int*)(F.ws + SM_HIST);
    {
        LAS int* wpart = (LAS int*)(F.lds + 2048);
        int c8[8];
#pragma unroll
        for (int e = 0; e < 8; ++e) c8[e] = 0;
        if (F.tid < GRID) { const u32x4 a0 = *(const u32x4*)(HIST + F.tid * 8), a1 = *(const u32x4*)(HIST + F.tid * 8 + 4); c8[0] = a0.x; c8[1] = a0.y; c8[2] = a0.z; c8[3] = a0.w; c8[4] = a1.x; c8[5] = a1.y; c8[6] = a1.z; c8[7] = a1.w; }
        if (F.wave < 4) {
#pragma unroll
            for (int e = 0; e < 8; ++e) { const float tsum = wave_sum((float)c8[e]), bsum = wave_sum((F.tid < F.blk) ? (float)c8[e] : 0.f);
                if (F.lane == 0) { wpart[F.wave * 16 + e] = (int)tsum; wpart[F.wave * 16 + 8 + e] = (int)bsum; } }
        }
        __syncthreads();
        if (F.tid < 16) tot[F.tid] = wpart[F.tid] + wpart[16 + F.tid] + wpart[32 + F.tid] + wpart[48 + F.tid];
    }
    __syncthreads();
    if (F.tid == 0) { int p = 0; for (int e = 0; e < 8; ++e) { tot[32 + e] = p; p += ((tot[e] + 255) >> 8) << 8; } tot[40] = p;
        if (F.blk == 0) { int* PS = (int*)(F.ws + SM_PSTART); for (int e = 0; e <= 8; ++e) PS[e] = tot[32 + e];
            int* PE = (int*)(F.ws + SM_PEXP); for (int e = 0; e < 8; ++e) for (int pp = tot[32 + e] >> 8; pp < (tot[32 + e + 1] >> 8); ++pp) PE[pp] = e; } }
    __syncthreads();
    int e0 = 0, e1 = 0, r0 = 0, r1 = 0;
    if (F.wave < 2) { const int row = F.blk * 128 + F.wave * 64 + F.lane; const int ew = ((const int*)(F.ws + SM_EW))[row]; e0 = ew & 255; e1 = ew >> 8;
#pragma unroll
        for (int e = 0; e < 8; ++e) { const bool f = (e0 == e) || (e1 == e); const unsigned long long mk = __ballot(f); const int rk = __popcll(mk & ((1ull << F.lane) - 1ull));
            if (e0 == e) r0 = rk; if (e1 == e) r1 = rk; if (F.lane == 0) tot[16 + F.wave * 8 + e] = __popcll(mk); } }
    __syncthreads();
    if (F.wave < 2) { const int row = F.blk * 128 + F.wave * 64 + F.lane;
        const int s0 = tot[32 + e0] + tot[8 + e0] + (F.wave == 1 ? tot[16 + e0] : 0) + r0, s1 = tot[32 + e1] + tot[8 + e1] + (F.wave == 1 ? tot[16 + e1] : 0) + r1;
        ((int*)(F.ws + SM_SLOT0))[row] = s0; ((int*)(F.ws + SM_SLOT1))[row] = s1; rslot[(F.wave * 64 + F.lane) * 2] = s0; rslot[(F.wave * 64 + F.lane) * 2 + 1] = s1; }
    __syncthreads();
    const float* gain = a->in[I_NFFN] + D; unsigned char* XG = (unsigned char*)F.out;
    {   f32x4 g[4];
#pragma unroll
        for (int j = 0; j < 4; ++j) g[j] = *(const f32x4*)(gain + rowcol(F.lane, j));
        const bf16* h0 = (const bf16*)(F.ws + WS_H) + (size_t)(F.blk * 128) * D + 8 * F.lane; const float* rsp = (const float*)(F.ws + SM_RS) + F.blk * 128;
        u32x4 ca = *(const u32x4*)(h0 + (size_t)F.wave * D), cb = *(const u32x4*)(h0 + (size_t)F.wave * D + 512); float crs = rsp[F.wave];
#pragma unroll 1
        for (int i = F.wave; i < 128; i += NWAVES) { const int ni = (i + NWAVES < 128) ? i + NWAVES : i;
            const u32x4 na = __builtin_nontemporal_load((const u32x4*)(h0 + (size_t)ni * D)), nb = __builtin_nontemporal_load((const u32x4*)(h0 + (size_t)ni * D + 512)); const float nrs = rsp[ni];
            const float rs = crs * SC_X8; f32x4 v[4]; unpack8(ca, v[0], v[1]); unpack8(cb, v[2], v[3]); const int s0 = rslot[i * 2], s1 = rslot[i * 2 + 1];
            u32x2 wa, wb;
            { const f32x4 o0 = v[0] * rs * g[0], o1 = v[1] * rs * g[1]; wa.x = pk4_fp8(o0[0], o0[1], o0[2], o0[3]); wa.y = pk4_fp8(o1[0], o1[1], o1[2], o1[3]); }
            { const f32x4 o2 = v[2] * rs * g[2], o3 = v[3] * rs * g[3]; wb.x = pk4_fp8(o2[0], o2[1], o2[2], o2[3]); wb.y = pk4_fp8(o3[0], o3[1], o3[2], o3[3]); }
            *(u32x2*)(XG + (size_t)s0 * D + 8 * F.lane) = wa; *(u32x2*)(XG + (size_t)s0 * D + 512 + 8 * F.lane) = wb;
            *(u32x2*)(XG + (size_t)s1 * D + 8 * F.lane) = wa; *(u32x2*)(XG + (size_t)s1 * D + 512 + 8 * F.lane) = wb;
            ca = na; cb = nb; crs = nrs; }
    }
}
struct EpiGU8 {
    unsigned char* ACT;
    __device__ __forceinline__ void put8x2(int row, int col, f32x4 g0, f32x4 g1, f32x4 u0, f32x4 u1) const {
        constexpr float si = 1.0f / (SC_X8 * SC_W8), ce = -si * LOG2E, kc = 1.0f / (si * si * SC_A8);
        f32x4 x0, x1;
#pragma unroll
        for (int e = 0; e < 4; ++e) { x0[e] = (g0[e] * u0[e]) * __builtin_amdgcn_rcpf(__builtin_fmaf(__builtin_amdgcn_exp2f(g0[e] * ce), kc, kc));
                                      x1[e] = (g1[e] * u1[e]) * __builtin_amdgcn_rcpf(__builtin_fmaf(__builtin_amdgcn_exp2f(g1[e] * ce), kc, kc)); }
        u32x2 w; w.x = pk4_fp8(x0[0], x0[1], x0[2], x0[3]); w.y = pk4_fp8(x1[0], x1[1], x1[2], x1[3]);
        *(u32x2*)(ACT + (size_t)row * DFF + col) = w;
    }
};
struct EpiY8 {
    bf16* Y;
    __device__ __forceinline__ void put8(int row, int col, f32x4 lo, f32x4 hi) const { constexpr float si = 1.0f / (SC_A8 * SC_W8); *(u32x4*)(Y + (size_t)row * D + col) = pack8(lo * si, hi * si); }
};
__device__ __forceinline__ void ph_moe_gu(const Frame& F0) {
    const Frame F = relaunder(F0);
    const int P = __builtin_amdgcn_readfirstlane(((const int*)(F.ws + SM_PSTART))[8] >> 8); const int* PE = (const int*)(F.ws + SM_PEXP);
    EpiGU8 E{F.ws + WS_ACTE};
    MoeOrder So; So.so.init(P, DFF / 128, F.G, F.blk); So.p0 = 0; So.PE = PE; So.nbt = DFF / 128; So.a_abs = 1;
    pg_gemm<1, EpiGU8, MoeOrder, true>(F, (const bf16*)F.out, (const bf16*)(F.ws + WS_WGUE), D, So, E);
}
__device__ __forceinline__ void ph_moe_down(const Frame& F0) {
    const Frame F = relaunder(F0);
    const int P = __builtin_amdgcn_readfirstlane(((const int*)(F.ws + SM_PSTART))[8] >> 8); const int* PE = (const int*)(F.ws + SM_PEXP);
    EpiY8 E{(bf16*)(F.ws + WS_Y)};
    MoeOrder So; So.so.init(P, D / 256, F.G, F.blk); So.so.rev = true; So.p0 = 0; So.PE = PE; So.nbt = D / 256; So.a_abs = 1;
    pg_gemm<0, EpiY8, MoeOrder, true>(F, (const bf16*)(F.ws + WS_ACTE), (const bf16*)(F.ws + WS_WDE), DFF, So, E);
}
__device__ __forceinline__ void ph_combine(const Frame& F0, KArgs a) {
    const Frame F = relaunder(F0);
    const bf16* Y = (const bf16*)(F.ws + WS_Y); const bf16* H = (const bf16*)(F.ws + WS_H); const float* gain = a->in[I_FNORM];
    {
        f32x4 g[4];
#pragma unroll
        for (int j = 0; j < 4; ++j) g[j] = *(const f32x4*)(gain + rowcol(F.lane, j));
        const int* SL0 = (const int*)(F.ws + SM_SLOT0); const int* SL1 = (const int*)(F.ws + SM_SLOT1); const float* W0 = (const float*)(F.ws + SM_W0); const float* W1 = (const float*)(F.ws + SM_W1);
        const int lo8 = 8 * F.lane;
        const int r0 = F.gw; const int r1 = (r0 + F.NGW < M) ? r0 + F.NGW : r0;
        int cs0 = SL0[r0], cs1 = SL1[r0]; float cw0 = W0[r0], cw1 = W1[r0];
        int ns0 = SL0[r1], ns1 = SL1[r1]; float nw0 = W0[r1], nw1 = W1[r1];
        u32x4 ch[2], cy[2], cz[2];
        ch[0] = *(const u32x4*)(H + (size_t)r0 * D + lo8); ch[1] = *(const u32x4*)(H + (size_t)r0 * D + 512 + lo8);
        cy[0] = *(const u32x4*)(Y + (size_t)cs0 * D + lo8); cy[1] = *(const u32x4*)(Y + (size_t)cs0 * D + 512 + lo8);
        cz[0] = *(const u32x4*)(Y + (size_t)cs1 * D + lo8); cz[1] = *(const u32x4*)(Y + (size_t)cs1 * D + 512 + lo8);
#pragma unroll 1
        for (int row = r0; row < M; row += F.NGW) {
            const int rn = (row + F.NGW < M) ? row + F.NGW : row, rnn = (rn + F.NGW < M) ? rn + F.NGW : rn;
            u32x4 nh[2], ny[2], nz[2];
            nh[0] = __builtin_nontemporal_load((const u32x4*)(H + (size_t)rn * D + lo8)); nh[1] = __builtin_nontemporal_load((const u32x4*)(H + (size_t)rn * D + 512 + lo8));
            ny[0] = *(const u32x4*)(Y + (size_t)ns0 * D + lo8); ny[1] = *(const u32x4*)(Y + (size_t)ns0 * D + 512 + lo8);
            nz[0] = *(const u32x4*)(Y + (size_t)ns1 * D + lo8); nz[1] = *(const u32x4*)(Y + (size_t)ns1 * D + 512 + lo8);
            const int fs0 = SL0[rnn], fs1 = SL1[rnn]; const float fw0 = W0[rnn], fw1 = W1[rnn];
            f32x4 v[4], ya[4], yb[4]; unpack8(ch[0], v[0], v[1]); unpack8(ch[1], v[2], v[3]); unpack8(cy[0], ya[0], ya[1]); unpack8(cy[1], ya[2], ya[3]); unpack8(cz[0], yb[0], yb[1]); unpack8(cz[1], yb[2], yb[3]);
#pragma unroll
            for (int j = 0; j < 4; ++j) v[j] = v[j] + ya[j] * cw0 + yb[j] * cw1;
            const float rs = row_rs(v);
            float* orow = F.out + (size_t)row * D;
#pragma unroll
            for (int j = 0; j < 4; ++j) __builtin_nontemporal_store(v[j] * rs * g[j], (f32x4*)(orow + rowcol(F.lane, j)));
            ch[0] = nh[0]; ch[1] = nh[1]; cy[0] = ny[0]; cy[1] = ny[1]; cz[0] = nz[0]; cz[1] = nz[1];
            cw0 = nw0; cw1 = nw1; ns0 = fs0; ns1 = fs1; nw0 = fw0; nw1 = fw1;
        }
    }
}

__device__ __forceinline__ bool opaque_true() { int one = 1; asm volatile("" : "+s"(one)); return one != 0; }
enum { PH_P0 = 0, PH_G1_0, PH_A_0, PH_G2_0, PH_G3_0, PH_N2_0, PH_F1_0, PH_F2_0, PH_N1_1, PH_G1_1, PH_A_1, PH_G2_1, PH_G3_1, PH_R1, PH_R2, PH_F1A, PH_F2A, PH_C, NPH };
__global__ void __launch_bounds__(NTHR, 2) fwd(Args args) {
    extern __shared__ __attribute__((aligned(16))) unsigned char lds_raw[];
    Frame F;
    F.lds = (LAS unsigned char*)lds_raw; F.ws = args.ws; F.out = args.out;
    F.tid = threadIdx.x; F.lane = F.tid & 63; F.wave = __builtin_amdgcn_readfirstlane(F.tid >> 6);
    F.G = gridDim.x; F.blk = blockIdx.x; F.gw = F.blk * NWAVES + F.wave; F.NGW = F.G * NWAVES;
    volatile LAS unsigned* MISC = (volatile LAS unsigned*)(F.lds + MISC_OFF);
    for (int u = F.tid; u < (LDS_BYTES - LDSCTL_OFF) / 4; u += NTHR) ((LAS unsigned*)(F.lds + LDSCTL_OFF))[u] = 0u;
    __syncthreads();
    XcdBarrier bar; bar.bar = (unsigned*)(F.ws + WS_CTL) + CW_BAR; bar.x = 0; bar.st = nullptr;
    if (NLAUNCH == 1) bar = xcd_barrier_post((unsigned*)(F.ws + WS_CTL) + CW_BAR, MISC + 8, F.tid);
    const int lo = args.ph_lo, hi = args.ph_hi;
#define IN(k) (NLAUNCH == 1 ? opaque_true() : (lo <= (k) && (k) < hi))
#define SEAM(k) do { if (NLAUNCH == 1) { XcdBarrier b2_ = bar; asm volatile("" : "+s"(b2_.bar)); xcd_barrier(b2_, F.wave); } } while (0)

    if (IN(PH_P0)) { ph_prologue(F, kargs()); } SEAM(PH_P0);
#pragma unroll 1
    for (int l = 0; l < 2; ++l) {
        const int pb = (l == 0) ? PH_G1_0 : PH_G1_1;
        if (l == 1) { if (IN(PH_N1_1)) { ph_norm(F, 1); } SEAM(PH_N1_1); }
        if (IN(pb)) { ph_inproj(F, l); } SEAM(pb);
        if (IN(pb + 1)) { ph_mixers(F, kargs(), l); } SEAM(pb + 1);
#if PROBE_DUP == 1
        if (IN(pb + 1)) { ph_mixers(F, kargs(), l); } SEAM(pb + 1);
#endif
        if (IN(pb + 2)) { ph_merge(F, l); } SEAM(pb + 2);
        if (IN(pb + 3)) { ph_outproj(F, kargs(), l); } SEAM(pb + 3);
        if (l == 0) {
            if (IN(PH_N2_0)) { ph_norm(F, 0); } SEAM(PH_N2_0);
            if (IN(PH_F1_0)) { ph_ffn_gu(F); } SEAM(PH_F1_0);
            if (IN(PH_F2_0)) { ph_ffn_down(F); } SEAM(PH_F2_0);
        }
    }
    if (IN(PH_R1)) { ph_route1(F, kargs()); } SEAM(PH_R1);
    if (IN(PH_R2)) { ph_route2(F, kargs()); } SEAM(PH_R2);
    if (IN(PH_F1A)) { ph_moe_gu(F); } SEAM(PH_F1A);
    if (IN(PH_F2A)) { ph_moe_down(F); } SEAM(PH_F2A);
    if (IN(PH_C)) { ph_combine(F, kargs()); }
#undef IN
#undef SEAM
}

extern "C" void kernel_launch(void* const* d_in, const int* in_sizes, int n_in, void* d_out, int out_size, void* d_ws, size_t ws_size, hipStream_t stream) {
    static int ready = 0;
    if (ready == 0) {
        if (n_in != 24 || in_sizes[0] != M * D || out_size != M * D || ws_size < WS_END) { fprintf(stderr, "kernel_launch: shape/workspace mismatch (n_in %d, in0 %d, out %d, ws %zu, need %zu)\n", n_in, n_in > 0 ? in_sizes[0] : -1, out_size, ws_size, (size_t)WS_END); ready = -1; return; }
        if (hipFuncSetAttribute((const void*)fwd, hipFuncAttributeMaxDynamicSharedMemorySize, LDS_BYTES) != hipSuccess) { fprintf(stderr, "kernel_launch: hipFuncSetAttribute failed\n"); ready = -1; return; }
        int per_cu = 0;
        if (hipOccupancyMaxActiveBlocksPerMultiprocessor(&per_cu, (const void*)fwd, NTHR, LDS_BYTES) != hipSuccess || per_cu < 1) fprintf(stderr, "kernel_launch: occupancy query reports %d\n", per_cu);
        (void)hipGetLastError();
        ready = 1;
    }
    if (ready < 0) return;
    (void)hipMemsetAsync((char*)d_ws + WS_CTL, 0, CTL_ZERO_BYTES, stream);
    Args a{};
    for (int i = 0; i < 24; ++i) a.in[i] = (const float*)d_in[i];
    a.out = (float*)d_out; a.ws = (unsigned char*)d_ws;
    for (int li = 0; li < NLAUNCH; ++li) {
        a.ph_lo = (NLAUNCH == 1) ? 0 : li; a.ph_hi = (NLAUNCH == 1) ? NPH : li + 1;
        hipLaunchKernelGGL(fwd, dim3(GRID), dim3(NTHR), LDS_BYTES, stream, a);
    }
}
```
